# Optimizing an MI355X kernel written in HIP

```python
import math
import jax, jax.numpy as jnp
from jax import lax
import numpy as np

D_MODEL = 1024
BATCH = 8
SEQ = 2048
DEPTH = 2

CHUNK = 64
Q_BLOCK = 128
RMS_EPS = 1e-6
LN_EPS = 1e-5
ROPE_THETA = 500000.0
ROPE_FRACTION = 4
DIFF_HEADS = D_MODEL // 256
DIFF_HEAD_DIM = 64
DIFF_WIDTH = DIFF_HEADS * 2 * DIFF_HEAD_DIM
CONV_CHANNELS = D_MODEL - DIFF_WIDTH
CONV_WIDTH = 31
SSM_CHANNELS = D_MODEL // 4
SSM_GROUP = 16
SSM_GROUPS = SSM_CHANNELS // SSM_GROUP
SSM_STATE = 64
DT_MIN = 1e-3
DT_MAX = 1e-1
MLA_V_DIM = 128
MLA_HEADS = (D_MODEL - SSM_CHANNELS) // MLA_V_DIM
MLA_NOPE_DIM = 128
MLA_ROPE_DIM = 64
MLA_Q_RANK = D_MODEL // 4
MLA_KV_RANK = D_MODEL // 8
MLA_ROPE_THETA = 10000.0
D_FF = -(-8 * D_MODEL // (3 * 256)) * 256
EVEN_IN = 3 * DIFF_WIDTH + 2 * CONV_CHANNELS
ODD_IN = SSM_CHANNELS + MLA_Q_RANK + MLA_KV_RANK + MLA_ROPE_DIM

kernel_name = 'chunk_causal_hybrid_diffattn_conformer_s5_mla'


def rmsnorm(x, g):
    x32 = x.astype(jnp.float32)
    y = x32 * lax.rsqrt(jnp.mean(x32 * x32, axis=-1, keepdims=True) + RMS_EPS)
    return (y * g.astype(jnp.float32)).astype(x.dtype)


def layernorm(x, g, b):
    x32 = x.astype(jnp.float32)
    mu = jnp.mean(x32, axis=-1, keepdims=True)
    xc = x32 - mu
    y = xc * lax.rsqrt(jnp.mean(xc * xc, axis=-1, keepdims=True) + LN_EPS)
    return (y * g.astype(jnp.float32) + b.astype(jnp.float32)).astype(x.dtype)


def rope_tables(s, rot_dim, theta):
    inv = theta ** (-jnp.arange(0, rot_dim, 2, dtype=jnp.float32) / rot_dim)
    ang = jnp.arange(s, dtype=jnp.float32)[:, None] * inv[None, :]
    return jnp.cos(ang), jnp.sin(ang)


def apply_rope(x, cos, sin):
    half = cos.shape[-1]
    shape = (1, cos.shape[0]) + (1,) * (x.ndim - 3) + (half,)
    c = cos.reshape(shape).astype(x.dtype)
    s = sin.reshape(shape).astype(x.dtype)
    x1 = x[..., :half]
    x2 = x[..., half:2 * half]
    return jnp.concatenate([x1 * c - x2 * s, x2 * c + x1 * s, x[..., 2 * half:]], axis=-1)


def chunk_causal_mask(i, s):
    qpos = i * Q_BLOCK + jnp.arange(Q_BLOCK)
    kpos = jnp.arange(s)
    return (kpos // CHUNK)[None, :] <= (qpos // CHUNK)[:, None]


def sweep_query_blocks(block_fn, q):
    b, s = q.shape[:2]
    nb = s // Q_BLOCK
    qb = jnp.moveaxis(q.reshape((b, nb, Q_BLOCK) + q.shape[2:]), 1, 0)
    out = lax.map(lambda a: block_fn(a[0], a[1]), (jnp.arange(nb), qb))
    out = jnp.moveaxis(out, 0, 1)
    return out.reshape((b, s) + out.shape[3:])


def sandwich(x, g_pre, g_post, fn):
    return x + rmsnorm(fn(rmsnorm(x, g_pre)), g_post)


def swiglu(h, w_gate, w_up, w_down):
    return (jax.nn.silu(h @ w_gate) * (h @ w_up)) @ w_down


def diff_attention(qkv, layer_idx, lq1, lk1, lq2, lk2, subln, cos, sin):
    b, s, _ = qkv.shape
    f32 = jnp.float32
    q = qkv[..., :DIFF_WIDTH].reshape(b, s, DIFF_HEADS, 2, DIFF_HEAD_DIM)
    k = qkv[..., DIFF_WIDTH:2 * DIFF_WIDTH].reshape(b, s, DIFF_HEADS, 2, DIFF_HEAD_DIM)
    v = qkv[..., 2 * DIFF_WIDTH:].reshape(b, s, DIFF_HEADS, 2 * DIFF_HEAD_DIM)
    q = apply_rope(q, cos, sin)
    k = apply_rope(k, cos, sin)
    lam_init = 0.8 - 0.6 * math.exp(-0.3 * layer_idx)
    lam = (jnp.exp(jnp.sum(lq1.astype(f32) * lk1.astype(f32)))
           - jnp.exp(jnp.sum(lq2.astype(f32) * lk2.astype(f32))) + lam_init)
    scale = DIFF_HEAD_DIM ** -0.5

    def block(i, qb):
        sc = jnp.einsum('bqhcd,bkhcd->bhcqk', qb, k, preferred_element_type=f32) * scale
        p = jax.nn.softmax(jnp.where(chunk_causal_mask(i, s), sc, -jnp.inf), axis=-1)
        w = p[:, :, 0] - lam * p[:, :, 1]
        return jnp.einsum('bhqk,bkhe->bqhe', w.astype(v.dtype), v)

    o = sweep_query_blocks(block, q)
    o = rmsnorm(o, subln) * (1.0 - lam_init)
    return o.reshape(b, s, DIFF_WIDTH)


def conformer_conv(g, dw_w, dw_b, ln_g, ln_b):
    u = g[..., :CONV_CHANNELS] * jax.nn.sigmoid(g[..., CONV_CHANNELS:])
    y = lax.conv_general_dilated(
        u, dw_w[:, None, :].astype(u.dtype), window_strides=(1,),
        padding=[(CONV_WIDTH - 1, 0)], dimension_numbers=('NWC', 'WIO', 'NWC'),
        feature_group_count=CONV_CHANNELS) + dw_b
    return jax.nn.silu(layernorm(y, ln_g, ln_b))


def s5_ssm(u, a_re, a_im, log_dt, b_re, b_im, c_re, c_im, d_skip, w_glu, b_glu):
    b, s, _ = u.shape
    f32 = jnp.float32
    ug = u.reshape(b, s, SSM_GROUPS, SSM_GROUP).astype(f32)
    lr = a_re.astype(f32)
    li = a_im.astype(f32)
    dt = jnp.exp(log_dt.astype(f32))[:, None]
    mag = jnp.exp(lr * dt)
    ab_re = mag * jnp.cos(li * dt)
    ab_im = mag * jnp.sin(li * dt)
    den = lr * lr + li * li
    n_re = ab_re - 1.0
    f_re = (n_re * lr + ab_im * li) / den
    f_im = (ab_im * lr - n_re * li) / den
    br = b_re.astype(f32)
    bi = b_im.astype(f32)
    bb_re = f_re[:, :, None] * br - f_im[:, :, None] * bi
    bb_im = f_re[:, :, None] * bi + f_im[:, :, None] * br
    bu_re = jnp.einsum('bsgh,gph->bsgp', ug, bb_re)
    bu_im = jnp.einsum('bsgh,gph->bsgp', ug, bb_im)
    aa_re = jnp.broadcast_to(ab_re, bu_re.shape)
    aa_im = jnp.broadcast_to(ab_im, bu_im.shape)

    def combine(e1, e2):
        ar1, ai1, xr1, xi1 = e1
        ar2, ai2, xr2, xi2 = e2
        return (ar2 * ar1 - ai2 * ai1, ar2 * ai1 + ai2 * ar1,
                ar2 * xr1 - ai2 * xi1 + xr2, ar2 * xi1 + ai2 * xr1 + xi2)

    _, _, x_re, x_im = lax.associative_scan(combine, (aa_re, aa_im, bu_re, bu_im), axis=1)
    y = (jnp.einsum('bsgp,ghp->bsgh', x_re, c_re.astype(f32))
         - jnp.einsum('bsgp,ghp->bsgh', x_im, c_im.astype(f32))
         + d_skip.astype(f32)[None, None] * ug)
    y = y.reshape(b, s, SSM_CHANNELS).astype(u.dtype)
    z = jax.nn.gelu(y)
    return z * jax.nn.sigmoid(z @ w_glu + b_glu)


def mla_attention(c_q, c_kv, k_r, q_norm, w_uq, kv_norm, w_ukv, cos, sin):
    b, s, _ = c_q.shape
    f32 = jnp.float32
    q = (rmsnorm(c_q, q_norm) @ w_uq).reshape(b, s, MLA_HEADS, MLA_NOPE_DIM + MLA_ROPE_DIM)
    q = jnp.concatenate([q[..., :MLA_NOPE_DIM], apply_rope(q[..., MLA_NOPE_DIM:], cos, sin)], axis=-1)
    kv = (rmsnorm(c_kv, kv_norm) @ w_ukv).reshape(b, s, MLA_HEADS, MLA_NOPE_DIM + MLA_V_DIM)
    k_rope = jnp.broadcast_to(apply_rope(k_r, cos, sin)[:, :, None, :], (b, s, MLA_HEADS, MLA_ROPE_DIM))
    k = jnp.concatenate([kv[..., :MLA_NOPE_DIM], k_rope], axis=-1)
    v = kv[..., MLA_NOPE_DIM:]
    scale = (MLA_NOPE_DIM + MLA_ROPE_DIM) ** -0.5

    def block(i, qb):
        sc = jnp.einsum('bqhd,bkhd->bhqk', qb, k, preferred_element_type=f32) * scale
        p = jax.nn.softmax(jnp.where(chunk_causal_mask(i, s), sc, -jnp.inf), axis=-1)
        return jnp.einsum('bhqk,bkhd->bqhd', p.astype(v.dtype), v)

    o = sweep_query_blocks(block, q)
    return o.reshape(b, s, MLA_HEADS * MLA_V_DIM)


def even_mixer(t, layer_idx, w_in, lq1, lk1, lq2, lk2, subln, dw_w, dw_b, ln_g, ln_b, w_out, cos, sin):
    proj = t @ w_in
    y_a = diff_attention(proj[..., :3 * DIFF_WIDTH], layer_idx, lq1, lk1, lq2, lk2, subln, cos, sin)
    y_b = conformer_conv(proj[..., 3 * DIFF_WIDTH:], dw_w, dw_b, ln_g, ln_b)
    return jnp.concatenate([y_a, y_b], axis=-1) @ w_out


def odd_mixer(t, w_in, a_re, a_im, log_dt, b_re, b_im, c_re, c_im, d_skip, w_glu, b_glu,
              q_norm, w_uq, kv_norm, w_ukv, w_out, cos, sin):
    proj = t @ w_in
    o1 = SSM_CHANNELS
    o2 = o1 + MLA_Q_RANK
    o3 = o2 + MLA_KV_RANK
    y_c = s5_ssm(proj[..., :o1], a_re, a_im, log_dt, b_re, b_im, c_re, c_im, d_skip, w_glu, b_glu)
    y_d = mla_attention(proj[..., o1:o2], proj[..., o2:o3], proj[..., o3:], q_norm, w_uq, kv_norm, w_ukv, cos, sin)
    return jnp.concatenate([y_c, y_d], axis=-1) @ w_out


def setup_inputs(seed: int = 0) -> dict:
    key = jax.random.key(seed)
    ks = iter(jax.random.split(key, 64))
    f32 = jnp.float32

    def nrm(shape, scale):
        return jax.random.normal(next(ks), shape, f32) * scale

    def gain(n):
        return 1.0 + 0.02 * jax.random.normal(next(ks), (n,), f32)

    d = D_MODEL
    inp = {}
    inp['x'] = nrm((BATCH, SEQ, d), 1.0)
    inp['l0_mix_pre'] = gain(d)
    inp['l0_mix_post'] = gain(d)
    inp['l0_w_in'] = nrm((d, EVEN_IN), d ** -0.5)
    inp['l0_lambda_q1'] = nrm((DIFF_HEAD_DIM,), 0.1)
    inp['l0_lambda_k1'] = nrm((DIFF_HEAD_DIM,), 0.1)
    inp['l0_lambda_q2'] = nrm((DIFF_HEAD_DIM,), 0.1)
    inp['l0_lambda_k2'] = nrm((DIFF_HEAD_DIM,), 0.1)
    inp['l0_subln'] = gain(2 * DIFF_HEAD_DIM)
    inp['l0_dw_w'] = nrm((CONV_WIDTH, CONV_CHANNELS), CONV_WIDTH ** -0.5)
    inp['l0_dw_b'] = nrm((CONV_CHANNELS,), 0.02)
    inp['l0_conv_ln_g'] = gain(CONV_CHANNELS)
    inp['l0_conv_ln_b'] = nrm((CONV_CHANNELS,), 0.02)
    inp['l0_w_out'] = nrm((DIFF_WIDTH + CONV_CHANNELS, d), (DIFF_WIDTH + CONV_CHANNELS) ** -0.5)
    inp['l0_ffn_pre'] = gain(d)
    inp['l0_ffn_post'] = gain(d)
    inp['l0_w_gate'] = nrm((d, D_FF), d ** -0.5)
    inp['l0_w_up'] = nrm((d, D_FF), d ** -0.5)
    inp['l0_w_down'] = nrm((D_FF, d), D_FF ** -0.5)
    inp['l1_mix_pre'] = gain(d)
    inp['l1_mix_post'] = gain(d)
    inp['l1_w_in'] = nrm((d, ODD_IN), d ** -0.5)
    inp['l1_a_re'] = -0.5 + nrm((SSM_GROUPS, SSM_STATE), 0.01)
    inp['l1_a_im'] = (jnp.pi * jnp.arange(SSM_STATE, dtype=f32))[None, :] + nrm((SSM_GROUPS, SSM_STATE), 0.01)
    inp['l1_log_dt'] = jax.random.uniform(next(ks), (SSM_GROUPS,), f32, math.log(DT_MIN), math.log(DT_MAX))
    inp['l1_b_re'] = nrm((SSM_GROUPS, SSM_STATE, SSM_GROUP), (2 * SSM_GROUP) ** -0.5)
    inp['l1_b_im'] = nrm((SSM_GROUPS, SSM_STATE, SSM_GROUP), (2 * SSM_GROUP) ** -0.5)
    inp['l1_c_re'] = nrm((SSM_GROUPS, SSM_GROUP, SSM_STATE), (2 * SSM_STATE) ** -0.5)
    inp['l1_c_im'] = nrm((SSM_GROUPS, SSM_GROUP, SSM_STATE), (2 * SSM_STATE) ** -0.5)
    inp['l1_d_skip'] = nrm((SSM_GROUPS, SSM_GROUP), 1.0)
    inp['l1_w_glu'] = nrm((SSM_CHANNELS, SSM_CHANNELS), SSM_CHANNELS ** -0.5)
    inp['l1_b_glu'] = nrm((SSM_CHANNELS,), 0.02)
    inp['l1_q_norm'] = gain(MLA_Q_RANK)
    inp['l1_w_uq'] = nrm((MLA_Q_RANK, MLA_HEADS * (MLA_NOPE_DIM + MLA_ROPE_DIM)), MLA_Q_RANK ** -0.5)
    inp['l1_kv_norm'] = gain(MLA_KV_RANK)
    inp['l1_w_ukv'] = nrm((MLA_KV_RANK, MLA_HEADS * (MLA_NOPE_DIM + MLA_V_DIM)), MLA_KV_RANK ** -0.5)
    inp['l1_w_out'] = nrm((SSM_CHANNELS + MLA_HEADS * MLA_V_DIM, d), (SSM_CHANNELS + MLA_HEADS * MLA_V_DIM) ** -0.5)
    inp['l1_ffn_pre'] = gain(d)
    inp['l1_ffn_post'] = gain(d)
    inp['l1_w_gate'] = nrm((d, D_FF), d ** -0.5)
    inp['l1_w_up'] = nrm((d, D_FF), d ** -0.5)
    inp['l1_w_down'] = nrm((D_FF, d), D_FF ** -0.5)
    return inp


def reference(x,
              l0_mix_pre, l0_mix_post, l0_w_in, l0_lambda_q1, l0_lambda_k1, l0_lambda_q2, l0_lambda_k2,
              l0_subln, l0_dw_w, l0_dw_b, l0_conv_ln_g, l0_conv_ln_b, l0_w_out,
              l0_ffn_pre, l0_ffn_post, l0_w_gate, l0_w_up, l0_w_down,
              l1_mix_pre, l1_mix_post, l1_w_in, l1_a_re, l1_a_im, l1_log_dt, l1_b_re, l1_b_im,
              l1_c_re, l1_c_im, l1_d_skip, l1_w_glu, l1_b_glu, l1_q_norm, l1_w_uq, l1_kv_norm, l1_w_ukv,
              l1_w_out, l1_ffn_pre, l1_ffn_post, l1_w_gate, l1_w_up, l1_w_down):
    s = x.shape[1]
    cos_a, sin_a = rope_tables(s, DIFF_HEAD_DIM // ROPE_FRACTION, ROPE_THETA)
    cos_d, sin_d = rope_tables(s, MLA_ROPE_DIM, MLA_ROPE_THETA)

    def layer0(h):
        h = sandwich(h, l0_mix_pre, l0_mix_post, lambda t: even_mixer(
            t, 0, l0_w_in, l0_lambda_q1, l0_lambda_k1, l0_lambda_q2, l0_lambda_k2, l0_subln,
            l0_dw_w, l0_dw_b, l0_conv_ln_g, l0_conv_ln_b, l0_w_out, cos_a, sin_a))
        return sandwich(h, l0_ffn_pre, l0_ffn_post, lambda t: swiglu(t, l0_w_gate, l0_w_up, l0_w_down))

    def layer1(h):
        h = sandwich(h, l1_mix_pre, l1_mix_post, lambda t: odd_mixer(
            t, l1_w_in, l1_a_re, l1_a_im, l1_log_dt, l1_b_re, l1_b_im, l1_c_re, l1_c_im, l1_d_skip,
            l1_w_glu, l1_b_glu, l1_q_norm, l1_w_uq, l1_kv_norm, l1_w_ukv, l1_w_out, cos_d, sin_d))
        return sandwich(h, l1_ffn_pre, l1_ffn_post, lambda t: swiglu(t, l1_w_gate, l1_w_up, l1_w_down))

    layers = (layer0, layer1)
    h = x
    for i in range(DEPTH):
        h = layers[i](h)
    return h
```

```cpp
#include <hip/hip_runtime.h>
#include <math.h>
#include <stdint.h>

constexpr int BATCH = 8, SEQ = 2048, DM = 1024, TOK = BATCH * SEQ;
constexpr int DFF = 2816;
constexpr int EVEN_IN = 2560, ODD_IN = 704;
constexpr float RMS_EPS = 1e-6f, LN_EPS = 1e-5f;

__device__ __forceinline__ float wave_sum(float v) {
#pragma unroll
    for (int o = 1; o < 64; o <<= 1) v += __shfl_xor(v, o);
    return v;
}
__device__ __forceinline__ float wave_max(float v) {
#pragma unroll
    for (int o = 1; o < 64; o <<= 1) v = fmaxf(v, __shfl_xor(v, o));
    return v;
}

__global__ __launch_bounds__(256) void k_rmsnorm(const float* in, int ldi, const float* g, const float* res, int ldr, float* out, int ldo, int rows, int D) {
    const int wave = threadIdx.x >> 6, lane = threadIdx.x & 63;
    const int row = blockIdx.x * 4 + wave;
    if (row >= rows) return;
    const float* ip = in + (size_t)row * ldi;
    float s = 0.f;
    for (int c = lane; c < D; c += 64) { float v = ip[c]; s += v * v; }
    s = wave_sum(s);
    const float rstd = 1.0f / sqrtf(s / (float)D + RMS_EPS);
    for (int c = lane; c < D; c += 64) {
        float v = ip[c] * rstd * g[c];
        if (res) v += res[(size_t)row * ldr + c];
        out[(size_t)row * ldo + c] = v;
    }
}

template <int MODE>
__global__ __launch_bounds__(256) void k_gemm(const float* A, int lda, const float* W, int ldw, float* C, int ldc, int K) {
    __shared__ float As[16][68];
    __shared__ float Bs[16][64];
    const int tx = threadIdx.x & 15, ty = threadIdx.x >> 4;
    const int m0 = blockIdx.y * 64, n0 = blockIdx.x * 64;
    float acc[4][4];
#pragma unroll
    for (int i = 0; i < 4; ++i)
#pragma unroll
        for (int j = 0; j < 4; ++j) acc[i][j] = 0.f;
    for (int k0 = 0; k0 < K; k0 += 16) {
#pragma unroll
        for (int i = 0; i < 4; ++i) { const int idx = threadIdx.x + i * 256; const int r = idx >> 4, kk = idx & 15; As[kk][r] = A[(size_t)(m0 + r) * lda + k0 + kk]; }
#pragma unroll
        for (int i = 0; i < 4; ++i) { const int idx = threadIdx.x + i * 256; const int kk = idx >> 6, c = idx & 63; Bs[kk][c] = W[(size_t)(k0 + kk) * ldw + n0 + c]; }
        __syncthreads();
#pragma unroll
        for (int kk = 0; kk < 16; ++kk) {
            float a[4], b[4];
#pragma unroll
            for (int i = 0; i < 4; ++i) a[i] = As[kk][ty * 4 + i];
#pragma unroll
            for (int j = 0; j < 4; ++j) b[j] = Bs[kk][tx * 4 + j];
#pragma unroll
            for (int i = 0; i < 4; ++i)
#pragma unroll
                for (int j = 0; j < 4; ++j) acc[i][j] += a[i] * b[j];
        }
        __syncthreads();
    }
#pragma unroll
    for (int i = 0; i < 4; ++i)
#pragma unroll
        for (int j = 0; j < 4; ++j) {
            float* cp = C + (size_t)(m0 + ty * 4 + i) * ldc + n0 + tx * 4 + j;
            if (MODE == 0) *cp = acc[i][j];
            else if (MODE == 1) { const float gsv = *cp; *cp = gsv / (1.f + expf(-gsv)) * acc[i][j]; }
            else *cp += acc[i][j];
        }
}

__global__ __launch_bounds__(256) void k_rope(float* buf, int ld, int col0, int nblk, int bstride, int half, float theta) {
    const int per = nblk * half;
    const size_t idx = (size_t)blockIdx.x * 256 + threadIdx.x;
    if (idx >= (size_t)TOK * per) return;
    const int t = (int)(idx / per), r = (int)(idx % per), j = r / half, i = r % half;
    const int s = t % SEQ;
    const float inv = powf(theta, -(float)(2 * i) / (float)(2 * half));
    const float ang = (float)s * inv;
    const float c = cosf(ang), sn = sinf(ang);
    float* p = buf + (size_t)t * ld + col0 + j * bstride;
    const float x1 = p[i], x2 = p[half + i];
    p[i] = x1 * c - x2 * sn;
    p[half + i] = x2 * c + x1 * sn;
}

__global__ __launch_bounds__(256) void k_attn(const float* Q1, int ldq1, int hq1, const float* K1, int ldk1, int hk1, int D1,
                                              const float* Q2, int ldq2, int hq2, const float* K2, int ldk2, int hk2, int D2,
                                              const float* V, int ldv, int hv, int vshift, float* O, int ldo, int ho, float scale, int nheads) {
    __shared__ float sc_all[4][SEQ];
    const int wave = threadIdx.x >> 6, lane = threadIdx.x & 63;
    float* sc = sc_all[wave];
    const int qi = blockIdx.x * 4 + wave;
    const int t = qi / nheads, hh = qi % nheads;
    const int b = t / SEQ, s = t % SEQ;
    const int nk = (s / 64 + 1) * 64;
    const float* q1 = Q1 + (size_t)t * ldq1 + hh * hq1;
    const float* q2 = D2 ? Q2 + (size_t)t * ldq2 + hh * hq2 : nullptr;
    float mx = -INFINITY;
    for (int k = lane; k < nk; k += 64) {
        const size_t kt = (size_t)b * SEQ + k;
        const float* k1 = K1 + kt * ldk1 + hh * hk1;
        float d = 0.f;
        for (int i = 0; i < D1; ++i) d += q1[i] * k1[i];
        if (D2) { const float* k2 = K2 + kt * ldk2 + hh * hk2; for (int i = 0; i < D2; ++i) d += q2[i] * k2[i]; }
        d *= scale;
        sc[k] = d;
        mx = fmaxf(mx, d);
    }
    mx = wave_max(mx);
    float sum = 0.f;
    for (int k = lane; k < nk; k += 64) { const float p = expf(sc[k] - mx); sc[k] = p; sum += p; }
    sum = wave_sum(sum);
    __syncthreads();
    const float inv = 1.f / sum;
    const float* vb = V + (size_t)b * SEQ * ldv + (hh >> vshift) * hv;
    float o0 = 0.f, o1 = 0.f;
    for (int k = 0; k < nk; ++k) { const float p = sc[k]; const float* vp = vb + (size_t)k * ldv; o0 += p * vp[lane]; o1 += p * vp[lane + 64]; }
    float* op = O + (size_t)t * ldo + hh * ho;
    op[lane] = o0 * inv; op[lane + 64] = o1 * inv;
}

__global__ __launch_bounds__(256) void k_diff_combine(const float* Oc, const float* lq1, const float* lk1, const float* lq2, const float* lk2, const float* subln, float* Y, int ldy) {
    const int wave = threadIdx.x >> 6, lane = threadIdx.x & 63;
    const int qi = blockIdx.x * 4 + wave;
    const int t = qi >> 2, h = qi & 3;
    const float d1 = wave_sum(lq1[lane] * lk1[lane]), d2 = wave_sum(lq2[lane] * lk2[lane]);
    const float lam_init = 0.8f - 0.6f * expf(-0.3f * 0.f);
    const float lam = expf(d1) - expf(d2) + lam_init;
    const float* o0 = Oc + ((size_t)t * 8 + h * 2) * 128;
    const float* o1 = o0 + 128;
    const float a = o0[lane] - lam * o1[lane], bq = o0[lane + 64] - lam * o1[lane + 64];
    const float ss = wave_sum(a * a + bq * bq);
    const float rstd = 1.f / sqrtf(ss / 128.f + RMS_EPS);
    float* y = Y + (size_t)t * ldy + h * 128;
    y[lane] = a * rstd * subln[lane] * (1.f - lam_init);
    y[lane + 64] = bq * rstd * subln[lane + 64] * (1.f - lam_init);
}

__global__ __launch_bounds__(256) void k_glu(const float* P, int ldp, int col0, float* U) {
    const size_t idx = (size_t)blockIdx.x * 256 + threadIdx.x;
    const int t = (int)(idx >> 9), c = (int)(idx & 511);
    const float a = P[(size_t)t * ldp + col0 + c], g = P[(size_t)t * ldp + col0 + 512 + c];
    U[idx] = a / (1.f + expf(-g));
}

__global__ __launch_bounds__(512) void k_conv_ln(const float* U, const float* dw_w, const float* dw_b, const float* ln_g, const float* ln_b, float* Y, int ldy) {
    __shared__ float red[8];
    __shared__ float bc[2];
    const int t = blockIdx.x, c = threadIdx.x, s = t % SEQ;
    float acc = dw_b[c];
    for (int j = 0; j < 31; ++j) { const int ss = s - 30 + j; if (ss >= 0) acc += U[(size_t)(t - 30 + j) * 512 + c] * dw_w[j * 512 + c]; }
    float v = wave_sum(acc);
    if ((c & 63) == 0) red[c >> 6] = v;
    __syncthreads();
    if (c == 0) { float m = 0.f; for (int i = 0; i < 8; ++i) m += red[i]; bc[0] = m / 512.f; }
    __syncthreads();
    const float mu = bc[0], xc = acc - mu;
    v = wave_sum(xc * xc);
    __syncthreads();
    if ((c & 63) == 0) red[c >> 6] = v;
    __syncthreads();
    if (c == 0) { float m = 0.f; for (int i = 0; i < 8; ++i) m += red[i]; bc[1] = 1.f / sqrtf(m / 512.f + LN_EPS); }
    __syncthreads();
    const float y = xc * bc[1] * ln_g[c] + ln_b[c];
    Y[(size_t)t * ldy + 512 + c] = y / (1.f + expf(-y));
}

__global__ __launch_bounds__(64) void k_ssm_scan(const float* P, int ldp, const float* a_re, const float* a_im, const float* log_dt, const float* b_re, const float* b_im,
                                                 const float* c_re, const float* c_im, const float* d_skip, float* Z) {
    const int b = blockIdx.x >> 4, g = blockIdx.x & 15, p = threadIdx.x;
    const float lr = a_re[g * 64 + p], li = a_im[g * 64 + p], dt = expf(log_dt[g]);
    const float mag = expf(lr * dt), abr = mag * cosf(li * dt), abi = mag * sinf(li * dt);
    const float den = lr * lr + li * li, nre = abr - 1.f;
    const float fre = (nre * lr + abi * li) / den, fim = (abi * lr - nre * li) / den;
    float bbr[16], bbi[16], cr[16], ci[16];
#pragma unroll
    for (int h = 0; h < 16; ++h) {
        const float br = b_re[(g * 64 + p) * 16 + h], bi = b_im[(g * 64 + p) * 16 + h];
        bbr[h] = fre * br - fim * bi; bbi[h] = fre * bi + fim * br;
        cr[h] = c_re[(g * 16 + h) * 64 + p]; ci[h] = c_im[(g * 16 + h) * 64 + p];
    }
    const float dsk = d_skip[g * 16 + (p & 15)];
    float xr = 0.f, xi = 0.f;
    for (int s = 0; s < SEQ; ++s) {
        const float* up = P + (size_t)(b * SEQ + s) * ldp + g * 16;
        float ur = 0.f, ui = 0.f, myu = 0.f;
#pragma unroll
        for (int h = 0; h < 16; ++h) { const float u = up[h]; ur += u * bbr[h]; ui += u * bbi[h]; if ((p & 15) == h) myu = u; }
        const float nxr = abr * xr - abi * xi + ur, nxi = abr * xi + abi * xr + ui;
        xr = nxr; xi = nxi;
        float yv = 0.f;
#pragma unroll
        for (int h = 0; h < 16; ++h) { const float v = wave_sum(xr * cr[h] - xi * ci[h]); if (p == h) yv = v; }
        if (p < 16) {
            const float y = yv + dsk * myu;
            const float z = 0.5f * y * (1.f + tanhf(0.7978845608028654f * (y + 0.044715f * y * y * y)));
            Z[(size_t)(b * SEQ + s) * 256 + g * 16 + p] = z;
        }
    }
}

__global__ __launch_bounds__(256) void k_ssm_gate(const float* Z, const float* G, const float* bias, float* Y) {
    const size_t idx = (size_t)blockIdx.x * 256 + threadIdx.x;
    const int c = (int)(idx & 255);
    const float z = Z[idx], g = G[idx] + bias[c];
    Y[idx] = z / (1.f + expf(-g));
}

static inline void gemm(int mode, const float* A, int lda, const float* W, int ldw, float* C, int ldc, int M, int N, int K, hipStream_t st) {
    dim3 grid(N / 64, M / 64), blk(256);
    if (mode == 0) k_gemm<0><<<grid, blk, 0, st>>>(A, lda, W, ldw, C, ldc, K);
    else if (mode == 1) k_gemm<1><<<grid, blk, 0, st>>>(A, lda, W, ldw, C, ldc, K);
    else k_gemm<2><<<grid, blk, 0, st>>>(A, lda, W, ldw, C, ldc, K);
}

extern "C" void kernel_launch(void* const* d_in, const int* in_sizes, int n_in, void* d_out, int out_size, void* d_ws, size_t ws_size, hipStream_t st) {
    const float* const* in = (const float* const*)d_in;
    const float* x = in[0];
    float* out = (float*)d_out;
    char* ws = (char*)d_ws;
    const size_t MiB = 1u << 20;
    auto F = [&](size_t mib) { return (float*)(ws + mib * MiB); };

    {
        float* t = F(0);
        float* proj = F(64);
        float* Oc = out;
        float* U = F(0);
        float* Y = F(64);
        float* mix = F(128);
        k_rmsnorm<<<TOK / 4, 256, 0, st>>>(x, DM, in[1], nullptr, 0, t, DM, TOK, DM);
        gemm(0, t, DM, in[3], EVEN_IN, proj, EVEN_IN, TOK, EVEN_IN, DM, st);
        k_rope<<<(TOK * 16 * 8 + 255) / 256, 256, 0, st>>>(proj, EVEN_IN, 0, 16, 64, 8, 500000.0f);
        k_attn<<<TOK * 8 / 4, 256, 0, st>>>(proj, EVEN_IN, 64, proj + 512, EVEN_IN, 64, 64, nullptr, 0, 0, nullptr, 0, 0, 0,
                                            proj + 1024, EVEN_IN, 128, 1, Oc, 1024, 128, 0.125f, 8);
        k_glu<<<TOK * 512 / 256, 256, 0, st>>>(proj, EVEN_IN, 1536, U);
        k_diff_combine<<<TOK * 4 / 4, 256, 0, st>>>(Oc, in[4], in[5], in[6], in[7], in[8], Y, DM);
        k_conv_ln<<<TOK, 512, 0, st>>>(U, in[9], in[10], in[11], in[12], Y, DM);
        gemm(0, Y, DM, in[13], DM, mix, DM, TOK, DM, DM, st);
        k_rmsnorm<<<TOK / 4, 256, 0, st>>>(mix, DM, in[2], x, DM, out, DM, TOK, DM);
        float* t2 = F(0); float* hid = F(64); float* dn = F(0);
        k_rmsnorm<<<TOK / 4, 256, 0, st>>>(out, DM, in[14], nullptr, 0, t2, DM, TOK, DM);
        gemm(0, t2, DM, in[16], DFF, hid, DFF, TOK, DFF, DM, st);
        gemm(1, t2, DM, in[17], DFF, hid, DFF, TOK, DFF, DM, st);
        gemm(0, hid, DFF, in[18], DM, dn, DM, TOK, DM, DFF, st);
        k_rmsnorm<<<TOK / 4, 256, 0, st>>>(dn, DM, in[15], out, DM, out, DM, TOK, DM);
    }
    {
        float* t = F(0);
        float* proj = F(64);
        float* cqn = F(108);
        float* ckvn = F(124);
        float* q = F(132);
        float* kn = F(0);
        float* vb = F(204);
        float* Z = F(48);
        float* G = F(108);
        float* Yc = F(48);
        float* mix = F(64);
        k_rmsnorm<<<TOK / 4, 256, 0, st>>>(out, DM, in[19], nullptr, 0, t, DM, TOK, DM);
        gemm(0, t, DM, in[21], ODD_IN, proj, ODD_IN, TOK, ODD_IN, DM, st);
        k_rmsnorm<<<TOK / 4, 256, 0, st>>>(proj + 256, ODD_IN, in[32], nullptr, 0, cqn, 256, TOK, 256);
        k_rmsnorm<<<TOK / 4, 256, 0, st>>>(proj + 512, ODD_IN, in[34], nullptr, 0, ckvn, 128, TOK, 128);
        gemm(0, cqn, 256, in[33], 1152, q, 1152, TOK, 1152, 256, st);
        for (int h = 0; h < 6; ++h) {
            gemm(0, ckvn, 128, in[35] + h * 256, 1536, kn + h * 128, 768, TOK, 128, 128, st);
            gemm(0, ckvn, 128, in[35] + h * 256 + 128, 1536, vb + h * 128, 768, TOK, 128, 128, st);
        }
        k_rope<<<(TOK * 6 * 32 + 255) / 256, 256, 0, st>>>(q, 1152, 128, 6, 192, 32, 10000.0f);
        k_rope<<<(TOK * 1 * 32 + 255) / 256, 256, 0, st>>>(proj, ODD_IN, 640, 1, 64, 32, 10000.0f);
        k_ssm_scan<<<BATCH * 16, 64, 0, st>>>(proj, ODD_IN, in[22], in[23], in[24], in[25], in[26], in[27], in[28], in[29], Z);
        gemm(0, Z, 256, in[30], 256, G, 256, TOK, 256, 256, st);
        k_ssm_gate<<<TOK * 256 / 256, 256, 0, st>>>(Z, G, in[31], Yc);
        k_attn<<<TOK * 6 / 4, 256, 0, st>>>(q, 1152, 192, kn, 768, 128, 128, q + 128, 1152, 192, proj + 640, ODD_IN, 0, 64,
                                            vb, 768, 128, 0, q, 1152, 192, 0.07216878364870323f, 6);
        gemm(0, Yc, 256, in[36], DM, mix, DM, TOK, DM, 256, st);
        for (int h = 0; h < 6; ++h) gemm(2, q + h * 192, 1152, in[36] + (size_t)(256 + 128 * h) * DM, DM, mix, DM, TOK, DM, 128, st);
        k_rmsnorm<<<TOK / 4, 256, 0, st>>>(mix, DM, in[20], out, DM, out, DM, TOK, DM);
    }
    {
        float* t2 = F(0); float* hid = F(64); float* dn = F(0);
        k_rmsnorm<<<TOK / 4, 256, 0, st>>>(out, DM, in[37], nullptr, 0, t2, DM, TOK, DM);
        gemm(0, t2, DM, in[39], DFF, hid, DFF, TOK, DFF, DM, st);
        gemm(1, t2, DM, in[40], DFF, hid, DFF, TOK, DFF, DM, st);
        gemm(0, hid, DFF, in[41], DM, dn, DM, TOK, DM, DFF, st);
        k_rmsnorm<<<TOK / 4, 256, 0, st>>>(dn, DM, in[38], out, DM, out, DM, TOK, DM);
    }
}
```

```cpp
#include <hip/hip_runtime.h>
#include <cstdio>
#include <cstdint>
#include <math.h>
namespace pg8 {
#define PG8_LAS __attribute__((address_space(3)))
typedef unsigned short bf16_t;
typedef short bf16x8 __attribute__((ext_vector_type(8)));
typedef float f32x4 __attribute__((ext_vector_type(4)));
typedef unsigned u32x4 __attribute__((ext_vector_type(4)));
constexpr int BM = 256, BK = 64, HALF = 128, HTB = HALF * BK * 2  , STAGE_BYTES = 8 * HTB, NXCD = 8, WGM = 8;

__host__ __device__ __forceinline__ int lds_byte(int r, int c) { const int st = (r >> 4) * 2 + (c >> 5), rr = r & 15, cc = c & 31, ob = rr * 64 + cc * 2; return st * 1024 + (ob ^ (((ob >> 9) & 1) << 5)); }
__host__ __device__ __forceinline__ void stage_rc(int b, int& R, int& C) { const int st = b / 1024, sb = b % 1024, swz = sb ^ (((sb >> 9) & 1) << 5); R = (st >> 1) * 16 + swz / 64; C = (st & 1) * 32 + (swz % 64) / 2; }
__host__ __device__ __forceinline__ int perm32(int rho) { const int n = rho >> 4, i = rho & 15; return 8 * (i >> 2) + 4 * n + (i & 3); }

struct Unit { int pm, pn; };
struct Gemm { const bf16_t* A; const bf16_t* Bt; int M, N, K; };

struct StaticOrder {
    int nM, nN, nwg, G, c;
    __host__ __device__ void init(int M, int N, int G_, int c_) { nM = M / BM; nN = N / BM; nwg = nM * nN; G = G_; c = c_; }
    __host__ __device__ bool next(int i, Unit& u) const {
        const long L = (long)i * G + c; if (L >= nwg) return false;
        int wgid = (int)L; { const int q = nwg / NXCD, r = nwg % NXCD, xcd = wgid % NXCD, off = wgid / NXCD; wgid = (xcd < r ? xcd * (q + 1) : r * (q + 1) + (xcd - r) * q) + off; }
        const int nig = WGM * nN, gid = wgid / nig, fm = gid * WGM, gsz = (nM - fm) < WGM ? (nM - fm) : WGM;
        u.pm = fm + ((wgid % nig) % gsz); u.pn = (wgid % nig) / gsz; return true;
    }
    __device__ __forceinline__ void a_ready(const Unit&) const {}
    __device__ __forceinline__ void done(const Unit&) const {}
};

#define MK_PER_PHASE 0

__device__ __forceinline__ unsigned cvt_pk_bf16(float lo, float hi) { unsigned r; asm volatile("v_cvt_pk_bf16_f32 %0, %1, %2" : "=v"(r) : "v"(lo), "v"(hi)); return r; }
__device__ __forceinline__ void st8(bf16_t* p, const f32x4 v0, const f32x4 v1) {
    u32x4 w; w.x = cvt_pk_bf16(v0[0], v0[1]); w.y = cvt_pk_bf16(v0[2], v0[3]); w.z = cvt_pk_bf16(v1[0], v1[1]); w.w = cvt_pk_bf16(v1[2], v1[3]); *(u32x4*)p = w;
}
__device__ __forceinline__ float sigm(float x) { return __builtin_amdgcn_rcpf(1.f + __builtin_amdgcn_exp2f(-1.4426950408889634f * x)); }
__device__ __forceinline__ float bf_lo(unsigned w) { return __uint_as_float(w << 16); }
__device__ __forceinline__ float bf_hi(unsigned w) { return __uint_as_float(w & 0xffff0000u); }

struct EpiF32 {
    static constexpr bool PERM = false, AFTER_DRAIN = false;
    float* C; int ldc;
    __device__ __forceinline__ void operator()(const f32x4 (&acc)[2][2][4][2], const Unit& u, int wr, int wc, int fr, int fq) const {
        const int row0 = u.pm * BM + wr * 64 + fr, col0 = u.pn * BM + wc * 32 + 4 * fq;
#pragma unroll
        for (int ai = 0; ai < 2; ++ai)
#pragma unroll
            for (int m = 0; m < 4; ++m) { float* rowp = C + (size_t)(row0 + ai * HALF + m * 16) * ldc + col0;
#pragma unroll
                for (int bj = 0; bj < 2; ++bj)
#pragma unroll
                    for (int n = 0; n < 2; ++n) *(f32x4*)(rowp + bj * HALF + n * 16) = acc[ai][bj][m][n]; }
    }
};
struct EpiBf16Plain {
    static constexpr bool PERM = true, AFTER_DRAIN = false;
    bf16_t* O; int ldc;
    __device__ __forceinline__ void operator()(const f32x4 (&acc)[2][2][4][2], const Unit& u, int wr, int wc, int fr, int fq) const {
        const int row0 = u.pm * BM + wr * 64 + fr, col0 = u.pn * BM + wc * 32 + 8 * fq;
#pragma unroll
        for (int ai = 0; ai < 2; ++ai)
#pragma unroll
            for (int m = 0; m < 4; ++m) { bf16_t* rowp = O + (size_t)(row0 + ai * HALF + m * 16) * ldc + col0;
#pragma unroll
                for (int bj = 0; bj < 2; ++bj) st8(rowp + bj * HALF, acc[ai][bj][m][0], acc[ai][bj][m][1]); }
    }
};
struct EpiProj0 {
    static constexpr bool PERM = true, AFTER_DRAIN = false;
    bf16_t *Q, *Kb, *V, *U; const float* ropeA; float qscale;
    __device__ __forceinline__ void operator()(const f32x4 (&acc)[2][2][4][2], const Unit& u, int wr, int wc, int fr, int fq) const {
        const int row0 = u.pm * BM + wr * 64 + fr, pn = u.pn;
        if (pn < 4) {
            bf16_t* base = (pn < 2 ? Q : Kb) + (pn & 1) * 256 + wc * 32 + 8 * fq;
            const float sc = pn < 2 ? qscale : 1.f;
            const bool ropew = (wc & 1) == 0;
            const bool ropel = fq < 2;
#pragma unroll
            for (int ai = 0; ai < 2; ++ai)
#pragma unroll
                for (int m = 0; m < 4; ++m) {
                    const int row = row0 + ai * HALF + m * 16;
                    f32x4 cs0 = {1.f, 0.f, 1.f, 0.f}, cs1 = {1.f, 0.f, 1.f, 0.f};
                    if (ropew) { const float* rp = ropeA + ((size_t)(row & 2047) * 8 + 4 * (fq & 1)) * 2; cs0 = *(const f32x4*)rp; cs1 = *(const f32x4*)(rp + 4); }
#pragma unroll
                    for (int bj = 0; bj < 2; ++bj) {
                        f32x4 v0 = acc[ai][bj][m][0], v1 = acc[ai][bj][m][1];
                        if (ropew) {
                            f32x4 r0, r1;
                            r0[0] = v0[0] * cs0[0] - v1[0] * cs0[1]; r1[0] = v1[0] * cs0[0] + v0[0] * cs0[1];
                            r0[1] = v0[1] * cs0[2] - v1[1] * cs0[3]; r1[1] = v1[1] * cs0[2] + v0[1] * cs0[3];
                            r0[2] = v0[2] * cs1[0] - v1[2] * cs1[1]; r1[2] = v1[2] * cs1[0] + v0[2] * cs1[1];
                            r0[3] = v0[3] * cs1[2] - v1[3] * cs1[3]; r1[3] = v1[3] * cs1[2] + v0[3] * cs1[3];
                            if (ropel) { v0 = r0; v1 = r1; }
                        }
                        st8(base + (size_t)row * 512 + bj * HALF, v0 * sc, v1 * sc);
                    }
                    asm volatile("" ::: "memory");
                }
        } else if (pn < 6) {
            bf16_t* base = V + (pn - 4) * 256 + wc * 32 + 8 * fq;
#pragma unroll
            for (int ai = 0; ai < 2; ++ai)
#pragma unroll
                for (int m = 0; m < 4; ++m) { const int row = row0 + ai * HALF + m * 16;
#pragma unroll
                    for (int bj = 0; bj < 2; ++bj) st8(base + (size_t)row * 512 + bj * HALF, acc[ai][bj][m][0], acc[ai][bj][m][1]); }
        } else {
            bf16_t* base = U + (pn - 6) * 128 + wc * 32 + 8 * fq;
#pragma unroll
            for (int ai = 0; ai < 2; ++ai)
#pragma unroll
                for (int m = 0; m < 4; ++m) { const int row = row0 + ai * HALF + m * 16;
                    f32x4 o[2];
#pragma unroll
                    for (int n = 0; n < 2; ++n)
#pragma unroll
                        for (int j = 0; j < 4; ++j) o[n][j] = acc[ai][0][m][n][j] * sigm(acc[ai][1][m][n][j]);
                    st8(base + (size_t)row * 512, o[0], o[1]); }
        }
    }
};
struct EpiGateUp {
    static constexpr bool PERM = true, AFTER_DRAIN = false;
    bf16_t* H; int ldh;
    __device__ __forceinline__ void operator()(const f32x4 (&acc)[2][2][4][2], const Unit& u, int wr, int wc, int fr, int fq) const {
        const int row0 = u.pm * BM + wr * 64 + fr;
        bf16_t* base = H + u.pn * 128 + wc * 32 + 8 * fq;
#pragma unroll
        for (int ai = 0; ai < 2; ++ai)
#pragma unroll
            for (int m = 0; m < 4; ++m) { const int row = row0 + ai * HALF + m * 16;
                f32x4 o[2];
#pragma unroll
                for (int n = 0; n < 2; ++n)
#pragma unroll
                    for (int j = 0; j < 4; ++j) { const float g = acc[ai][0][m][n][j]; o[n][j] = g * sigm(g) * acc[ai][1][m][n][j]; }
                st8(base + (size_t)row * ldh, o[0], o[1]); }
    }
};
struct EpiQup {
    static constexpr bool PERM = true, AFTER_DRAIN = false;
    bf16_t* Q1; const float* ropeD; float qscale;
    __device__ __forceinline__ void operator()(const f32x4 (&acc)[2][2][4][2], const Unit& u, int wr, int wc, int fr, int fq) const {
        const int row0 = u.pm * BM + wr * 64 + fr;
#pragma unroll
        for (int bj = 0; bj < 2; ++bj) {
            const int cw = u.pn * BM + bj * HALF + wc * 32;
            if (cw >= 1152) continue;
            const bool rope = ((cw >> 6) % 3) == 2;
            const int i0 = 16 * (wc & 1) + 4 * fq;
#pragma unroll
            for (int ai = 0; ai < 2; ++ai)
#pragma unroll
                for (int m = 0; m < 4; ++m) { const int row = row0 + ai * HALF + m * 16;
                    f32x4 v0 = acc[ai][bj][m][0], v1 = acc[ai][bj][m][1];
                    if (rope) {
                        const float* rp = ropeD + ((size_t)(row & 2047) * 32 + i0) * 2; const f32x4 cs0 = *(const f32x4*)rp, cs1 = *(const f32x4*)(rp + 4);
                        f32x4 r0, r1;
                        r0[0] = v0[0] * cs0[0] - v1[0] * cs0[1]; r1[0] = v1[0] * cs0[0] + v0[0] * cs0[1];
                        r0[1] = v0[1] * cs0[2] - v1[1] * cs0[3]; r1[1] = v1[1] * cs0[2] + v0[1] * cs0[3];
                        r0[2] = v0[2] * cs1[0] - v1[2] * cs1[1]; r1[2] = v1[2] * cs1[0] + v0[2] * cs1[1];
                        r0[3] = v0[3] * cs1[2] - v1[3] * cs1[3]; r1[3] = v1[3] * cs1[2] + v0[3] * cs1[3];
                        v0 = r0; v1 = r1;
                    }
                    st8(Q1 + (size_t)row * 1152 + cw + 8 * fq, v0 * qscale, v1 * qscale); asm volatile("" ::: "memory"); }
        }
    }
};
struct EpiSsmGate {
    static constexpr bool PERM = true, AFTER_DRAIN = false;
    const bf16_t* Z; const float* bias; bf16_t* Y; int ldy;
    __device__ __forceinline__ void operator()(const f32x4 (&acc)[2][2][4][2], const Unit& u, int wr, int wc, int fr, int fq) const {
        const int row0 = u.pm * BM + wr * 64 + fr;
#pragma unroll
        for (int bj = 0; bj < 2; ++bj) {
            const int c0 = bj * HALF + wc * 32 + 8 * fq;
            const f32x4 b0 = *(const f32x4*)(bias + c0), b1 = *(const f32x4*)(bias + c0 + 4);
#pragma unroll
            for (int ai = 0; ai < 2; ++ai)
#pragma unroll
                for (int m = 0; m < 4; ++m) { const int row = row0 + ai * HALF + m * 16;
                    const u32x4 zw = *(const u32x4*)(Z + (size_t)row * 256 + c0);
                    f32x4 o0, o1;
                    o0[0] = bf_lo(zw.x) * sigm(acc[ai][bj][m][0][0] + b0[0]); o0[1] = bf_hi(zw.x) * sigm(acc[ai][bj][m][0][1] + b0[1]);
                    o0[2] = bf_lo(zw.y) * sigm(acc[ai][bj][m][0][2] + b0[2]); o0[3] = bf_hi(zw.y) * sigm(acc[ai][bj][m][0][3] + b0[3]);
                    o1[0] = bf_lo(zw.z) * sigm(acc[ai][bj][m][1][0] + b1[0]); o1[1] = bf_hi(zw.z) * sigm(acc[ai][bj][m][1][1] + b1[1]);
                    o1[2] = bf_lo(zw.w) * sigm(acc[ai][bj][m][1][2] + b1[2]); o1[3] = bf_hi(zw.w) * sigm(acc[ai][bj][m][1][3] + b1[3]);
                    st8(Y + (size_t)row * ldy + c0, o0, o1); asm volatile("" ::: "memory"); }
        }
    }
};

template <class Epi, class Sched, bool ALIGN_EPI = false, bool SP2 = false>
__device__ __forceinline__ void gemm_phase(PG8_LAS unsigned char* lds, const Gemm g, const Sched& S, const Epi& E, const int wid  ) {
    int lane_ = __builtin_amdgcn_mbcnt_hi(~0u, __builtin_amdgcn_mbcnt_lo(~0u, 0u)); asm volatile("" : "+v"(lane_));
    const int lane = lane_, tid = wid * 64 + lane, wr = wid >> 2, wc = wid & 3, fr = lane & 15, fq = lane >> 4;
    const int K = g.K, nt = K / BK;
    unsigned voffA[2], voffB[2];
#pragma unroll
    for (int i = 0; i < 2; ++i) { int R, C; stage_rc(tid * 16 + i * 8192, R, C); const int Rb = Epi::PERM ? ((R & ~31) + perm32(R & 31)) : R;
        voffA[i] = (unsigned)(R * K + C) * 2u; voffB[i] = (unsigned)(Rb * K + C) * 2u; }
    const size_t kstep = (size_t)(BK * 2);
    const size_t hstep = (size_t)HALF * K * 2;
    const size_t tstep = 2 * hstep;
    const unsigned ldsw = (unsigned)wid * 1024u;
    const int aoff = lds_byte(wr * 64 + fr, fq * 8), boff = lds_byte(wc * 32 + fr, fq * 8);
#define PG8_SA(b, h) (((b) * 2 + (h)) * HTB)
#define PG8_SB(b, h) ((4 + (b) * 2 + (h)) * HTB)
#define PG8_STAGE(bufoff, gbase, voff) do { _Pragma("unroll") for (int _i = 0; _i < 2; ++_i) \
        __builtin_amdgcn_global_load_lds((const unsigned*)((const char*)(gbase) + (voff)[_i]), (PG8_LAS unsigned*)(lds + (bufoff) + ldsw + _i * 8192), 16, 0, 0); } while (0)
#define PG8_LDA(dst, b, h) do { _Pragma("unroll") for (int m = 0; m < 4; ++m) _Pragma("unroll") for (int k = 0; k < 2; ++k) dst[m][k] = *(const PG8_LAS bf16x8*)(lds + PG8_SA(b, h) + aoff + m * 2048 + k * 1024); } while (0)
#define PG8_LDB(dst, b, h) do { _Pragma("unroll") for (int n = 0; n < 2; ++n) _Pragma("unroll") for (int k = 0; k < 2; ++k) dst[n][k] = *(const PG8_LAS bf16x8*)(lds + PG8_SB(b, h) + boff + n * 2048 + k * 1024); } while (0)
#define PG8_MMA(ai, bj, At, Bt) do { __builtin_amdgcn_s_setprio(1); _Pragma("unroll") for (int m = 0; m < 4; ++m) _Pragma("unroll") for (int n = 0; n < 2; ++n) _Pragma("unroll") for (int k = 0; k < 2; ++k) \
        acc[ai][bj][m][n] = __builtin_amdgcn_mfma_f32_16x16x32_bf16(Bt[n][k], At[m][k], acc[ai][bj][m][n], 0, 0, 0); __builtin_amdgcn_s_setprio(0); } while (0)
#define PG8_WAIT_V(n) asm volatile("s_waitcnt vmcnt(" #n ")" ::: "memory")
#define PG8_WAIT_L(n) asm volatile("s_waitcnt lgkmcnt(" #n ")" ::: "memory")
#define PG8_BAR __builtin_amdgcn_s_barrier()
#define PG8_SCHED __builtin_amdgcn_sched_barrier(0)
    Unit cur, nxt; int ui = 0;
    if (!S.next(0, cur)) return;
    f32x4 acc[2][2][4][2];
#pragma unroll
    for (int a = 0; a < 2; ++a)
#pragma unroll
        for (int b = 0; b < 2; ++b)
#pragma unroll
            for (int m = 0; m < 4; ++m)
#pragma unroll
                for (int n = 0; n < 2; ++n) acc[a][b][m][n] = (f32x4){0.f, 0.f, 0.f, 0.f};
    bf16x8 At[4][2], B0[2][2], B1[2][2];
    const char* cA = (const char*)g.A + (size_t)cur.pm * tstep; const char* cB = (const char*)g.Bt + (size_t)cur.pn * tstep;
    S.a_ready(cur);
    if constexpr (SP2) {
        PG8_STAGE(PG8_SB(0, 0), cB, voffB); PG8_STAGE(PG8_SB(0, 1), cB + hstep, voffB); PG8_STAGE(PG8_SA(0, 0), cA, voffA); PG8_STAGE(PG8_SA(0, 1), cA + hstep, voffA);
        if (wr == 1) PG8_BAR;
        PG8_WAIT_V(2); PG8_BAR;
        PG8_STAGE(PG8_SB(1, 0), cB + kstep, voffB); PG8_STAGE(PG8_SA(1, 0), cA + kstep, voffA); PG8_STAGE(PG8_SB(1, 1), cB + hstep + kstep, voffB);
        PG8_WAIT_V(6); PG8_BAR;
    } else {
        PG8_STAGE(PG8_SB(0, 0), cB, voffB); PG8_STAGE(PG8_SA(0, 0), cA, voffA); PG8_STAGE(PG8_SB(0, 1), cB + hstep, voffB); PG8_STAGE(PG8_SA(0, 1), cA + hstep, voffA);
        if (wr == 1) PG8_BAR;
        PG8_WAIT_V(4); PG8_BAR;
        PG8_STAGE(PG8_SB(1, 0), cB + kstep, voffB); PG8_STAGE(PG8_SA(1, 0), cA + kstep, voffA); PG8_STAGE(PG8_SB(1, 1), cB + hstep + kstep, voffB);
        PG8_WAIT_V(6); PG8_BAR;
    }
    for (;;) {
        const bool has_next = S.next(ui + 1, nxt);
        const char* nA = has_next ? (const char*)g.A + (size_t)nxt.pm * tstep : cA; const char* nB = has_next ? (const char*)g.Bt + (size_t)nxt.pn * tstep : cB;
        for (int t = 0; t < nt; t += 2) {
            const bool last = (t == nt - 2);
            const char* a1 = cA + (size_t)(t + 1) * kstep;
            const char* a2 = last ? nA : cA + (size_t)(t + 2) * kstep; const char* b2 = last ? nB : cB + (size_t)(t + 2) * kstep;
            const char* a3 = a2 + kstep; const char* b3 = b2 + kstep;
            if (last && has_next) S.a_ready(nxt);
            if constexpr (SP2) {
            PG8_LDB(B0, 0, 0); PG8_LDB(B1, 0, 1); PG8_SCHED; PG8_LDA(At, 0, 0); PG8_STAGE(PG8_SA(1, 1), a1 + hstep, voffA);
            PG8_WAIT_V(8); PG8_WAIT_L(0); PG8_BAR; PG8_MMA(0, 0, At, B0); PG8_MMA(0, 1, At, B1); PG8_BAR; PG8_SCHED;
            PG8_LDA(At, 0, 1); PG8_STAGE(PG8_SB(0, 0), b2, voffB); PG8_STAGE(PG8_SB(0, 1), b2 + hstep, voffB); PG8_STAGE(PG8_SA(0, 0), a2, voffA);
            PG8_WAIT_V(8); PG8_WAIT_L(0); PG8_BAR; PG8_MMA(1, 0, At, B0); PG8_MMA(1, 1, At, B1); PG8_BAR; PG8_SCHED;
            PG8_LDB(B0, 1, 0); PG8_LDB(B1, 1, 1); PG8_SCHED; PG8_LDA(At, 1, 0); PG8_STAGE(PG8_SA(0, 1), a2 + hstep, voffA);
            PG8_WAIT_V(8); PG8_WAIT_L(0); PG8_BAR; PG8_MMA(0, 0, At, B0); PG8_MMA(0, 1, At, B1); PG8_BAR; PG8_SCHED;
            PG8_LDA(At, 1, 1); PG8_STAGE(PG8_SB(1, 0), b3, voffB); PG8_STAGE(PG8_SB(1, 1), b3 + hstep, voffB); PG8_STAGE(PG8_SA(1, 0), a3, voffA);
            PG8_WAIT_V(8); PG8_WAIT_L(0); PG8_BAR; PG8_MMA(1, 0, At, B0); PG8_MMA(1, 1, At, B1); PG8_BAR; PG8_SCHED;
            } else {
            PG8_LDB(B0, 0, 0); PG8_SCHED; PG8_LDA(At, 0, 0); PG8_STAGE(PG8_SA(1, 1), a1 + hstep, voffA);
            PG8_WAIT_L(8); PG8_BAR; PG8_WAIT_L(0); PG8_MMA(0, 0, At, B0); PG8_BAR; PG8_SCHED;
            PG8_LDB(B1, 0, 1); PG8_STAGE(PG8_SB(0, 0), b2, voffB);
            PG8_BAR; PG8_WAIT_L(0); PG8_MMA(0, 1, At, B1); PG8_BAR;
            PG8_LDA(At, 0, 1); PG8_STAGE(PG8_SA(0, 0), a2, voffA);
            PG8_BAR; PG8_WAIT_L(0); PG8_MMA(1, 0, At, B0); PG8_BAR; PG8_SCHED;
            PG8_STAGE(PG8_SB(0, 1), b2 + hstep, voffB);
            PG8_WAIT_V(6); PG8_BAR; PG8_MMA(1, 1, At, B1); PG8_BAR;
            PG8_LDB(B0, 1, 0); PG8_SCHED; PG8_LDA(At, 1, 0); PG8_STAGE(PG8_SA(0, 1), a2 + hstep, voffA);
            PG8_WAIT_L(8); PG8_BAR; PG8_WAIT_L(0); PG8_MMA(0, 0, At, B0); PG8_BAR; PG8_SCHED;
            PG8_LDB(B1, 1, 1); PG8_STAGE(PG8_SB(1, 0), b3, voffB);
            PG8_BAR; PG8_WAIT_L(0); PG8_MMA(0, 1, At, B1); PG8_BAR;
            PG8_LDA(At, 1, 1); PG8_STAGE(PG8_SA(1, 0), a3, voffA);
            PG8_BAR; PG8_WAIT_L(0); PG8_MMA(1, 0, At, B0); PG8_BAR; PG8_SCHED;
            PG8_STAGE(PG8_SB(1, 1), b3 + hstep, voffB);
            PG8_WAIT_V(6); PG8_BAR; PG8_MMA(1, 1, At, B1); PG8_BAR;
            }
        }
        if constexpr (ALIGN_EPI) { if (wr == 0) PG8_BAR; }
        if constexpr (!Epi::AFTER_DRAIN) { E(acc, cur, wr, wc, fr, fq); S.done(cur); }
        if (!has_next) break;
#pragma unroll
        for (int a = 0; a < 2; ++a)
#pragma unroll
            for (int b = 0; b < 2; ++b)
#pragma unroll
                for (int m = 0; m < 4; ++m)
#pragma unroll
                    for (int n = 0; n < 2; ++n) acc[a][b][m][n] = (f32x4){0.f, 0.f, 0.f, 0.f};
        cur = nxt; cA = nA; cB = nB; ++ui;
        if constexpr (ALIGN_EPI) { if (wr == 1) PG8_BAR; }
    }
    PG8_WAIT_V(0);
    if constexpr (!ALIGN_EPI) { if (wr == 0) PG8_BAR; }
    PG8_BAR;
    if constexpr (Epi::AFTER_DRAIN) { E.fused(acc, cur, wr, wc, fr, fq, lds, wid, lane); S.done(cur); }
#undef PG8_SA
#undef PG8_SB
#undef PG8_STAGE
#undef PG8_LDA
#undef PG8_LDB
#undef PG8_MMA
#undef PG8_WAIT_V
#undef PG8_WAIT_L
#undef PG8_BAR
#undef PG8_SCHED
}
}

#define LAS __attribute__((address_space(3)))
typedef unsigned short bf16;
typedef float f32x4 __attribute__((ext_vector_type(4)));
typedef unsigned u32x4 __attribute__((ext_vector_type(4)));
typedef unsigned u32x2 __attribute__((ext_vector_type(2)));

constexpr int NWAVES = 8, NTHREADS = 512;
constexpr int BATCH = 8, SEQ = 2048, DM = 1024, TOK = BATCH * SEQ, DFF = 2816;
constexpr float RMS_EPS = 1e-6f, LN_EPS = 1e-5f;
constexpr float LOG2E = 1.4426950408889634f;
constexpr int LDS_BYTES = 147456;

#ifndef MK_PER_PHASE
#define MK_PER_PHASE 0
#endif

constexpr size_t MiB = 1u << 20;
constexpr size_t WS_ROPEA = 1 * MiB, WS_ROPED = 1 * MiB + 128 * 1024;
constexpr size_t WS_W0IN = 2 * MiB, WS_W0OUT = 7 * MiB, WS_W0GU = 9 * MiB, WS_W0DN = 20 * MiB;
constexpr size_t WS_W1IN = 26 * MiB, WS_W1UQ = 28 * MiB, WS_W1UKV = 29 * MiB, WS_W1GLU = 30 * MiB, WS_W1OUT = 31 * MiB, WS_W1GU = 33 * MiB, WS_W1DN = 44 * MiB;
constexpr size_t WS_H = 50 * MiB;
constexpr size_t WS_Q = 50 * MiB, WS_K = 66 * MiB, WS_V = 82 * MiB, WS_U = 98 * MiB;
constexpr size_t WS_Q1 = 50 * MiB, WS_KV1 = 86 * MiB;
constexpr size_t WS_MIX = 138 * MiB;
constexpr size_t WS_Z = 186 * MiB;
constexpr size_t WS_XN = 202 * MiB;
constexpr size_t WS_CQN = 234 * MiB, WS_CKVN = 242 * MiB, WS_KR = 250 * MiB;
constexpr size_t WS_END = 256 * MiB;

__device__ __forceinline__ float bf2f(unsigned short u) { return __uint_as_float((unsigned)u << 16); }
__device__ __forceinline__ unsigned f2bf(float f) { unsigned u = __builtin_bit_cast(unsigned, f); return (u + 0x7fffu + ((u >> 16) & 1u)) >> 16; }
__device__ __forceinline__ unsigned pk2(float lo, float hi) { return f2bf(lo) | (f2bf(hi) << 16); }
__device__ __forceinline__ float wave_sum(float v) {
#pragma unroll
    for (int o = 1; o < 64; o <<= 1) v += __shfl_xor(v, o);
    return v;
}
__device__ __forceinline__ float wave_max(float v) {
#pragma unroll
    for (int o = 1; o < 64; o <<= 1) v = fmaxf(v, __shfl_xor(v, o));
    return v;
}
__device__ __forceinline__ float bf_lo_(unsigned w) { return __uint_as_float(w << 16); }
__device__ __forceinline__ float bf_hi_(unsigned w) { return __uint_as_float(w & 0xffff0000u); }
__device__ __forceinline__ int fresh_lane() { int l = __builtin_amdgcn_mbcnt_hi(~0u, __builtin_amdgcn_mbcnt_lo(~0u, 0u)); asm volatile("" : "+v"(l)); return l; }
__device__ __forceinline__ float dot4(const f32x4 a, const f32x4 b) { return (a[0] * b[0] + a[1] * b[1]) + (a[2] * b[2] + a[3] * b[3]); }

struct Args { const float* in[42]; float* out; unsigned char* ws; int ph_lo, ph_hi; };
typedef const Args __attribute__((address_space(4)))* ArgsP;
__device__ __forceinline__ ArgsP launder(ArgsP p) { asm volatile("" : "+s"(p)); return p; }

__device__ __forceinline__ int permA(int p) { if (p >= 16) return p; const int g = p >> 3, j = p & 7; return (j < 4) ? 4 * g + j : 8 + 4 * g + (j - 4); }
__device__ __forceinline__ int permD(int p) { const int wl = p >> 5, fq = (p >> 3) & 3, j = p & 7; return (j < 4) ? 16 * wl + 4 * fq + j : 32 + 16 * wl + 4 * fq + (j - 4); }

struct WMat { int K, N, Ksrc; size_t off; };
__device__ __forceinline__ WMat wmat(int m) {
    switch (m) {
        case 0: return WMat{1024, 2560, 1024, WS_W0IN};
        case 1: return WMat{1024, 1024, 1024, WS_W0OUT};
        case 2: return WMat{1024, 5632, 1024, WS_W0GU};
        case 3: return WMat{2816, 1024, 2816, WS_W0DN};
        case 4: return WMat{1024, 768, 1024, WS_W1IN};
        case 5: return WMat{256, 1280, 256, WS_W1UQ};
        case 6: return WMat{256, 1536, 128, WS_W1UKV};
        case 7: return WMat{256, 256, 256, WS_W1GLU};
        case 8: return WMat{1024, 1024, 1024, WS_W1OUT};
        case 9: return WMat{1024, 5632, 1024, WS_W1GU};
        default: return WMat{2816, 1024, 2816, WS_W1DN};
    }
}
__device__ __forceinline__ const float* wsrc(ArgsP a, int m, int n, int& ld) {
    switch (m) {
        case 0: { ld = 2560; int c;
            if (n < 1024) c = (n & ~63) + permA(n & 63);
            else if (n < 1536) c = n;
            else { const int r = n - 1536, t = r >> 8, rr = r & 255; c = rr < 128 ? 1536 + 128 * t + rr : 2048 + 128 * t + (rr - 128); }
            return a->in[3] + c; }
        case 1: ld = 1024; return a->in[13] + n;
        case 2: { ld = 2816; const int j = n >> 8, rr = n & 255; return rr < 128 ? a->in[16] + 128 * j + rr : a->in[17] + 128 * j + (rr - 128); }
        case 3: ld = 1024; return a->in[18] + n;
        case 4: { ld = 704; if (n >= 704) return nullptr; return a->in[21] + n; }
        case 5: { ld = 1152; if (n >= 1152) return nullptr; const int blk = n >> 6; return a->in[33] + ((blk % 3) == 2 ? (n & ~63) + permD(n & 63) : n); }
        case 6: ld = 1536; return a->in[35] + n;
        case 7: ld = 256; return a->in[30] + n;
        case 8: ld = 1024; return a->in[36] + n;
        case 9: { ld = 2816; const int j = n >> 8, rr = n & 255; return rr < 128 ? a->in[39] + 128 * j + rr : a->in[40] + 128 * j + (rr - 128); }
        default: ld = 1024; return a->in[41] + n;
    }
}
__device__ __forceinline__ void p0_transpose_item(ArgsP a, int m, const WMat w, int item, LAS float* scr, int lane) {
    const int nblk = w.N / 32, kb = item / nblk, nb = item % nblk, k0 = 64 * kb, n0 = 32 * nb;
    int ld; const float* src = wsrc(a, m, n0 + (lane & 31), ld);
#pragma unroll 8
    for (int i = 0; i < 32; ++i) { const int kk = 2 * i + (lane >> 5); const int k = k0 + kk;
        scr[kk * 33 + (lane & 31)] = (src != nullptr && k < w.Ksrc) ? src[(size_t)k * ld] : 0.f; }
    asm volatile("s_waitcnt lgkmcnt(0)" ::: "memory");
    bf16* WT = (bf16*)(a->ws + w.off);
    const int c = lane & 7;
#pragma unroll
    for (int j = 0; j < 4; ++j) { const int n = (lane >> 3) + 8 * j; const LAS float* s = scr + (8 * c) * 33 + n;
        u32x4 o; o.x = pk2(s[0 * 33], s[1 * 33]); o.y = pk2(s[2 * 33], s[3 * 33]); o.z = pk2(s[4 * 33], s[5 * 33]); o.w = pk2(s[6 * 33], s[7 * 33]);
        *(u32x4*)(WT + (size_t)(n0 + n) * w.K + k0 + 8 * c) = o; }
    asm volatile("s_waitcnt lgkmcnt(0)" ::: "memory");
}

__device__ __forceinline__ void row_norm(const float* xrow, const float* g, bf16* xn, int lane) {
    f32x4 v[4]; float s = 0.f;
#pragma unroll
    for (int j = 0; j < 4; ++j) { v[j] = ((const f32x4*)xrow)[lane + 64 * j]; s += dot4(v[j], v[j]); }
    const float rstd = 1.0f / sqrtf(wave_sum(s) * (1.f / DM) + RMS_EPS);
#pragma unroll
    for (int j = 0; j < 4; ++j) { const f32x4 gg = ((const f32x4*)g)[lane + 64 * j]; const f32x4 t = v[j] * rstd * gg;
        u32x2 o; o.x = pk2(t[0], t[1]); o.y = pk2(t[2], t[3]); ((u32x2*)xn)[lane + 64 * j] = o; }
}
__device__ __forceinline__ void row_norm_res(const float* mix, const float* res, const float* gpost, float* out, const float* gpre, bf16* xn, int lane) {
    f32x4 v[4]; float s = 0.f;
#pragma unroll
    for (int j = 0; j < 4; ++j) { v[j] = ((const f32x4*)mix)[lane + 64 * j]; s += dot4(v[j], v[j]); }
    const float rstd = 1.0f / sqrtf(wave_sum(s) * (1.f / DM) + RMS_EPS);
    float s2 = 0.f;
#pragma unroll
    for (int j = 0; j < 4; ++j) { const f32x4 gg = ((const f32x4*)gpost)[lane + 64 * j]; const f32x4 r = ((const f32x4*)res)[lane + 64 * j];
        v[j] = r + v[j] * rstd * gg; ((f32x4*)out)[lane + 64 * j] = v[j]; s2 += dot4(v[j], v[j]); }
    if (xn) {
        const float rstd2 = 1.0f / sqrtf(wave_sum(s2) * (1.f / DM) + RMS_EPS);
#pragma unroll
        for (int j = 0; j < 4; ++j) { const f32x4 gg = ((const f32x4*)gpre)[lane + 64 * j]; const f32x4 t = v[j] * rstd2 * gg;
            u32x2 o; o.x = pk2(t[0], t[1]); o.y = pk2(t[2], t[3]); ((u32x2*)xn)[lane + 64 * j] = o; }
    }
}
__device__ __forceinline__ void row_latent(const float* p, int s, const float* qg, const float* kvg, const float* ropeD, bf16* cqn, bf16* ckvn, bf16* kr, int lane) {
    { const f32x4 v = ((const f32x4*)(p + 256))[lane]; const float rstd = 1.0f / sqrtf(wave_sum(dot4(v, v)) * (1.f / 256.f) + RMS_EPS);
      const f32x4 t = v * rstd * ((const f32x4*)qg)[lane]; u32x2 o; o.x = pk2(t[0], t[1]); o.y = pk2(t[2], t[3]); ((u32x2*)cqn)[lane] = o; }
    { f32x4 v = {0.f, 0.f, 0.f, 0.f}; if (lane < 32) v = ((const f32x4*)(p + 512))[lane];
      const float rstd = 1.0f / sqrtf(wave_sum(dot4(v, v)) * (1.f / 128.f) + RMS_EPS);
      f32x4 t = {0.f, 0.f, 0.f, 0.f}; if (lane < 32) t = v * rstd * ((const f32x4*)kvg)[lane];
      u32x2 o; o.x = pk2(t[0], t[1]); o.y = pk2(t[2], t[3]); ((u32x2*)ckvn)[lane] = o; }
    if (lane < 32) { const int d = lane; const float x1 = p[640 + d], x2 = p[672 + d]; const float c = ropeD[((size_t)s * 32 + d) * 2], sn = ropeD[((size_t)s * 32 + d) * 2 + 1];
      const int p1 = 32 * (d >> 4) + 8 * ((d >> 2) & 3) + (d & 3);
      kr[p1] = (bf16)f2bf(x1 * c - x2 * sn); kr[p1 + 4] = (bf16)f2bf(x2 * c + x1 * sn); }
}

__device__ __forceinline__ float dot8(const u32x4 a, const u32x4 b) {
    return (bf_lo_(a.x) * bf_lo_(b.x) + bf_hi_(a.x) * bf_hi_(b.x)) + (bf_lo_(a.y) * bf_lo_(b.y) + bf_hi_(a.y) * bf_hi_(b.y))
         + (bf_lo_(a.z) * bf_lo_(b.z) + bf_hi_(a.z) * bf_hi_(b.z)) + (bf_lo_(a.w) * bf_lo_(b.w) + bf_hi_(a.w) * bf_hi_(b.w));
}
__device__ __forceinline__ void attn_row_naive(const bf16* q1, const bf16* k1, int ldk1, int D1, const bf16* q2, const bf16* k2, int ldk2, int D2,
                                               const bf16* v, int ldv, int nk, LAS float* sc, int lane, float& o0, float& o1) {
    float mx = -INFINITY;
    for (int k = lane; k < nk; k += 64) {
        const bf16* kp = k1 + (size_t)k * ldk1; float d = 0.f;
        for (int i = 0; i < D1; i += 8) d += dot8(*(const u32x4*)(q1 + i), *(const u32x4*)(kp + i));
        if (D2) { const bf16* kp2 = k2 + (size_t)k * ldk2; for (int i = 0; i < D2; i += 8) d += dot8(*(const u32x4*)(q2 + i), *(const u32x4*)(kp2 + i)); }
        sc[k] = d; mx = fmaxf(mx, d);
    }
    mx = wave_max(mx);
    float sum = 0.f;
    for (int k = lane; k < nk; k += 64) { const float p = exp2f(sc[k] - mx); sc[k] = p; sum += p; }
    sum = wave_sum(sum);
    asm volatile("s_waitcnt lgkmcnt(0)" ::: "memory");
    float a0 = 0.f, a1 = 0.f;
    for (int k = 0; k < nk; ++k) { const float p = sc[k]; const bf16* vp = v + (size_t)k * ldv; a0 += p * bf2f(vp[lane]); a1 += p * bf2f(vp[lane + 64]); }
    const float inv = 1.f / sum; o0 = a0 * inv; o1 = a1 * inv;
    asm volatile("s_waitcnt lgkmcnt(0)" ::: "memory");
}

#define GAS __attribute__((address_space(1)))
typedef GAS unsigned gu32;
#define RLX_AGENT __ATOMIC_RELAXED, __HIP_MEMORY_SCOPE_AGENT
constexpr int CW_BAR = 4096;
constexpr size_t CTL_ZERO_BYTES = 64 * 1024;
constexpr int LDSCTL_OFF = 131072, MISC_OFF = LDSCTL_OFF + 320;
#define XB_TMO      128
#define XB_XCNT(j)  (256  + 64 * (j))
#define XB_XSUB(j)  (1280 + 64 * (j))
#define XB_XGEN(j)  (2304 + 64 * (j))
#define XB_TOP      3328
#define XB_TOPGEN   3392
#define XCD_BAR_WORDS 3456
#define XB_SPIN_CAP (1u << 18)

__device__ __forceinline__ unsigned xb_ld(unsigned* p)              { return __hip_atomic_load(p, __ATOMIC_RELAXED, __HIP_MEMORY_SCOPE_AGENT); }
__device__ __forceinline__ unsigned xb_add(unsigned* p, unsigned v) { return __hip_atomic_fetch_add(p, v, __ATOMIC_RELAXED, __HIP_MEMORY_SCOPE_AGENT); }
__device__ __forceinline__ unsigned xb_xcc_id() { return (unsigned)__builtin_amdgcn_s_getreg((3 << 11) | 20) & 0xFu; }
#define XB_SPIN(cond, bar) do { unsigned _sp = 0; while (cond) { __builtin_amdgcn_s_sleep(1); \
    if ((++_sp & 255u) == 0u) { if (xb_ld(&(bar)[XB_TMO])) break; if (_sp > XB_SPIN_CAP) { atomicAdd(&(bar)[XB_TMO], 1u); break; } } } } while (0)

struct XcdBarrier {
    unsigned* bar; unsigned x;
    volatile LAS unsigned* st;
};

__device__ __forceinline__ XcdBarrier xcd_barrier_post(unsigned* bar, volatile LAS unsigned* st, bool leader) {
    XcdBarrier b; b.bar = bar; b.x = xb_xcc_id(); b.st = st;
    if (leader) (void)xb_add(&bar[XB_XCNT(b.x)], 1u);
    return b;
}
__device__ __forceinline__ void xcd_barrier_complete(unsigned* bar, unsigned x, unsigned& nloc, unsigned& nx) {
    const unsigned G = gridDim.x * gridDim.y * gridDim.z;
    unsigned sum, cnt, mine, sp = 0u;
    for (;;) {
        sum = 0u; cnt = 0u; mine = 0u;
#pragma unroll
        for (unsigned j = 0; j < 16; ++j) { const unsigned c = xb_ld(&bar[XB_XCNT(j)]); sum += c; cnt += (c > 0u) ? 1u : 0u; mine = (j == x) ? c : mine; }
        if (sum == G) break;
        __builtin_amdgcn_s_sleep(1);
        if ((++sp & 255u) == 0u) { if (xb_ld(&bar[XB_TMO])) break; if (sp > XB_SPIN_CAP) { atomicAdd(&bar[XB_TMO], 1u); break; } }
    }
    nloc = mine > 0u ? mine : 1u; nx = cnt > 0u ? cnt : 1u;
}

__device__ __forceinline__ void xcd_barrier(const XcdBarrier& b, bool leader) {
    asm volatile("s_waitcnt vmcnt(0)" ::: "memory");
    __syncthreads();
    if (leader) {
        unsigned* bar = b.bar;
        __builtin_amdgcn_s_waitcnt(0);
        unsigned nloc = b.st[0], nx = b.st[1];
        if (nloc == 0u) { xcd_barrier_complete(bar, b.x, nloc, nx); b.st[0] = nloc; b.st[1] = nx; }
        const unsigned old = xb_add(&bar[XB_XSUB(b.x)], 1u);
        const unsigned gen = old / nloc;
        if (old + 1u == (gen + 1u) * nloc) {
            __builtin_amdgcn_fence(__ATOMIC_RELEASE, "agent");
            asm volatile("s_waitcnt vmcnt(0)" ::: "memory");
            const unsigned og = xb_add(&bar[XB_TOP], 1u);
            const unsigned tg = og / nx;
            if (og + 1u == (tg + 1u) * nx) xb_add(&bar[XB_TOPGEN], 1u);
            else XB_SPIN(xb_ld(&bar[XB_TOPGEN]) == tg, bar);
            __builtin_amdgcn_fence(__ATOMIC_ACQUIRE, "agent");
            xb_add(&bar[XB_XGEN(b.x)], 1u);
            asm volatile("s_waitcnt vmcnt(0)" ::: "memory");
        } else {
            XB_SPIN(xb_ld(&bar[XB_XGEN(b.x)]) == gen, bar);
            __builtin_amdgcn_fence(__ATOMIC_ACQUIRE, "agent");
            asm volatile("s_waitcnt vmcnt(0)" ::: "memory");
        }
    }
    __syncthreads();
}

constexpr int NPHASE = 17;
__global__ void __launch_bounds__(NTHREADS, 2) mega_fwd(Args a_unused) {
    extern __shared__ __attribute__((aligned(16))) unsigned char lds_raw[];
    LAS unsigned char* lds = (LAS unsigned char*)lds_raw;
    const int wave = __builtin_amdgcn_readfirstlane(threadIdx.x >> 6);
    const int G = gridDim.x, bid = blockIdx.x;
    const int gw = bid * NWAVES + wave, NGW = G * NWAVES;
    const ArgsP ap0 = (ArgsP)__builtin_amdgcn_kernarg_segment_ptr();
    for (int u = wave * 64 + fresh_lane(); u < (LDS_BYTES - LDSCTL_OFF) / 4; u += NTHREADS) ((LAS unsigned*)(lds + LDSCTL_OFF))[u] = 0u;
    __syncthreads();
    XcdBarrier bar; bar.bar = (unsigned*)(ap0->ws) + CW_BAR; bar.x = 0; bar.st = nullptr;
#if !MK_PER_PHASE
    bar = xcd_barrier_post((unsigned*)(ap0->ws) + CW_BAR, (volatile LAS unsigned*)(lds + MISC_OFF) + 8, wave == 0 && fresh_lane() == 0);
#endif
    const int lo = ap0->ph_lo, hi = ap0->ph_hi;
#define IN(k) (lo <= (k) && (k) < hi)
#define PTRS const int lane = fresh_lane(); (void)lane; ArgsP a = launder(ap0); unsigned char* ws = a->ws; (void)ws; \
        float* ropeA = (float*)(ws + WS_ROPEA); float* ropeD = (float*)(ws + WS_ROPED); bf16* XN = (bf16*)(ws + WS_XN); bf16* Y = (bf16*)(ws + WS_XN); \
        float* MIX = (float*)(ws + WS_MIX); float* P1OUT = (float*)(ws + WS_MIX); bf16* Hb = (bf16*)(ws + WS_H); \
        bf16* Qb = (bf16*)(ws + WS_Q); bf16* Kb = (bf16*)(ws + WS_K); bf16* Vb = (bf16*)(ws + WS_V); bf16* Ub = (bf16*)(ws + WS_U); \
        bf16* Q1 = (bf16*)(ws + WS_Q1); bf16* KV1 = (bf16*)(ws + WS_KV1); bf16* Zb = (bf16*)(ws + WS_Z); bf16* CQN = (bf16*)(ws + WS_CQN); bf16* CKVN = (bf16*)(ws + WS_CKVN); bf16* KR = (bf16*)(ws + WS_KR); \
        float* out = a->out; (void)ropeA; (void)ropeD; (void)XN; (void)Y; (void)MIX; (void)P1OUT; (void)Hb; (void)Qb; (void)Kb; (void)Vb; (void)Ub; (void)Q1; (void)KV1; (void)Zb; (void)CQN; (void)CKVN; (void)KR; (void)out;
#define SEAM(k) do { if (IN(k) && IN((k) + 1)) xcd_barrier(bar, wave == 0 && fresh_lane() == 0); } while (0)
#define GEMM_RUN(EpiT, E, Aptr, Bptr, M_, N_, K_, coff) do { int kk_ = (K_); asm volatile("" : "+s"(kk_));   \
        pg8::Gemm g_{(const pg8::bf16_t*)(Aptr), (const pg8::bf16_t*)(Bptr), M_, N_, kk_}; pg8::StaticOrder S_; \
        S_.init(M_, N_, G, (bid + (coff)) % G); pg8::gemm_phase<EpiT, pg8::StaticOrder, true, true>(lds, g_, S_, E, wave); } while (0)

    if (IN(0)) { PTRS
        LAS float* scr = (LAS float*)(lds + wave * 16384);
        int base = 0;
        for (int m = 0; m < 11; ++m) {
            const WMat w = wmat(m); const int nitems = (w.K / 64) * (w.N / 32);
            int j = (gw - base % NGW + NGW) % NGW;
            for (; j < nitems; j += NGW) p0_transpose_item(a, m, w, j, scr, lane);
            base += nitems;
        }
        for (int i = gw * 64 + lane; i < SEQ * 8; i += NGW * 64) { const int s = i >> 3, k = i & 7; const float inv = powf(500000.0f, -(float)(2 * k) / 16.0f); const float ang = (float)s * inv;
            ropeA[2 * i] = cosf(ang); ropeA[2 * i + 1] = sinf(ang); }
        for (int i = gw * 64 + lane; i < SEQ * 32; i += NGW * 64) { const int s = i >> 5, k = i & 31; const float inv = powf(10000.0f, -(float)(2 * k) / 64.0f); const float ang = (float)s * inv;
            ropeD[2 * i] = cosf(ang); ropeD[2 * i + 1] = sinf(ang); }
        for (int r = gw; r < TOK; r += NGW) row_norm(a->in[0] + (size_t)r * DM, a->in[1], XN + (size_t)r * DM, lane);
    }
    SEAM(0);
    if (IN(1)) { PTRS
        pg8::EpiProj0 E{Qb, Kb, Vb, Ub, ropeA, 0.125f * LOG2E};
        GEMM_RUN(pg8::EpiProj0, E, XN, ws + WS_W0IN, TOK, 2560, 1024, 0);
    }
    SEAM(1);
    if (IN(2)) { PTRS
        LAS float* sc = (LAS float*)lds + wave * SEQ;
        const float d1 = wave_sum(a->in[4][lane] * a->in[5][lane]), d2 = wave_sum(a->in[6][lane] * a->in[7][lane]);
        const float lam_init = 0.2f;
        const float lam = expf(d1) - expf(d2) + lam_init;
        const float sub0 = a->in[8][lane] * (1.f - lam_init), sub1 = a->in[8][lane + 64] * (1.f - lam_init);
        for (int item = gw; item < TOK * 4; item += NGW) {
            const int t = item >> 2, h = item & 3, b = t / SEQ, s = t % SEQ, nk = (s / 64 + 1) * 64;
            const bf16* q = Qb + (size_t)t * 512 + h * 128;
            const bf16* kb = Kb + (size_t)b * SEQ * 512 + h * 128;
            const bf16* vb = Vb + (size_t)b * SEQ * 512 + h * 128;
            float a0, a1, b0, b1;
            attn_row_naive(q, kb, 512, 64, nullptr, nullptr, 0, 0, vb, 512, nk, sc, lane, a0, a1);
            attn_row_naive(q + 64, kb + 64, 512, 64, nullptr, nullptr, 0, 0, vb, 512, nk, sc, lane, b0, b1);
            const float x0 = a0 - lam * b0, x1 = a1 - lam * b1;
            const float rstd = 1.0f / sqrtf(wave_sum(x0 * x0 + x1 * x1) * (1.f / 128.f) + RMS_EPS);
            bf16* y = Y + (size_t)t * DM + h * 128;
            y[lane] = (bf16)f2bf(x0 * rstd * sub0); y[lane + 64] = (bf16)f2bf(x1 * rstd * sub1);
        }
        const float* dw_w = a->in[9]; const float* dw_b = a->in[10]; const float* ln_g = a->in[11]; const float* ln_b = a->in[12];
        for (int t = gw; t < TOK; t += NGW) {
            const int s = t % SEQ;
            f32x4 c0 = ((const f32x4*)dw_b)[2 * lane], c1 = ((const f32x4*)dw_b)[2 * lane + 1];
            for (int j = 0; j < 31; ++j) {
                if (s - 30 + j < 0) continue;
                const u32x4 uw = *(const u32x4*)(Ub + (size_t)(t - 30 + j) * 512 + 8 * lane);
                const f32x4 w0 = ((const f32x4*)(dw_w + j * 512))[2 * lane], w1 = ((const f32x4*)(dw_w + j * 512))[2 * lane + 1];
                c0[0] += bf_lo_(uw.x) * w0[0]; c0[1] += bf_hi_(uw.x) * w0[1]; c0[2] += bf_lo_(uw.y) * w0[2]; c0[3] += bf_hi_(uw.y) * w0[3];
                c1[0] += bf_lo_(uw.z) * w1[0]; c1[1] += bf_hi_(uw.z) * w1[1]; c1[2] += bf_lo_(uw.w) * w1[2]; c1[3] += bf_hi_(uw.w) * w1[3];
            }
            const float mu = wave_sum((c0[0] + c0[1]) + (c0[2] + c0[3]) + (c1[0] + c1[1]) + (c1[2] + c1[3])) * (1.f / 512.f);
            c0 = c0 - mu; c1 = c1 - mu;
            const float rstd = 1.0f / sqrtf(wave_sum(dot4(c0, c0) + dot4(c1, c1)) * (1.f / 512.f) + LN_EPS);
            const f32x4 g0 = ((const f32x4*)ln_g)[2 * lane], g1 = ((const f32x4*)ln_g)[2 * lane + 1], e0 = ((const f32x4*)ln_b)[2 * lane], e1 = ((const f32x4*)ln_b)[2 * lane + 1];
            f32x4 y0 = c0 * rstd * g0 + e0, y1 = c1 * rstd * g1 + e1;
#pragma unroll
            for (int k = 0; k < 4; ++k) { y0[k] = y0[k] * pg8::sigm(y0[k]); y1[k] = y1[k] * pg8::sigm(y1[k]); }
            u32x4 o; o.x = pk2(y0[0], y0[1]); o.y = pk2(y0[2], y0[3]); o.z = pk2(y1[0], y1[1]); o.w = pk2(y1[2], y1[3]);
            *(u32x4*)(Y + (size_t)t * DM + 512 + 8 * lane) = o;
        }
    }
    SEAM(2);
    if (IN(3)) { PTRS pg8::EpiF32 E{MIX, DM}; GEMM_RUN(pg8::EpiF32, E, Y, ws + WS_W0OUT, TOK, DM, DM, 0); }
    SEAM(3);
    if (IN(4)) { PTRS for (int r = gw; r < TOK; r += NGW) row_norm_res(MIX + (size_t)r * DM, a->in[0] + (size_t)r * DM, a->in[2], out + (size_t)r * DM, a->in[14], XN + (size_t)r * DM, lane); }
    SEAM(4);
    if (IN(5)) { PTRS pg8::EpiGateUp E{Hb, DFF}; GEMM_RUN(pg8::EpiGateUp, E, XN, ws + WS_W0GU, TOK, 2 * DFF, DM, 0); }
    SEAM(5);
    if (IN(6)) { PTRS pg8::EpiF32 E{MIX, DM}; GEMM_RUN(pg8::EpiF32, E, Hb, ws + WS_W0DN, TOK, DM, DFF, 0); }
    SEAM(6);
    if (IN(7)) { PTRS for (int r = gw; r < TOK; r += NGW) row_norm_res(MIX + (size_t)r * DM, out + (size_t)r * DM, a->in[15], out + (size_t)r * DM, a->in[19], XN + (size_t)r * DM, lane); }
    SEAM(7);
    if (IN(8)) { PTRS pg8::EpiF32 E{P1OUT, 768}; GEMM_RUN(pg8::EpiF32, E, XN, ws + WS_W1IN, TOK, 768, DM, 0); }
    SEAM(8);
    if (IN(9)) { PTRS
        for (int r = gw; r < TOK; r += NGW) row_latent(P1OUT + (size_t)r * 768, r % SEQ, a->in[32], a->in[34], ropeD, CQN + (size_t)r * 256, CKVN + (size_t)r * 256, KR + (size_t)r * 64, lane);
        if (bid < BATCH * 16 && wave == 0) {
            const int b = bid >> 4, g = bid & 15, p = lane;
            const float lr = a->in[22][g * 64 + p], li = a->in[23][g * 64 + p], dt = expf(a->in[24][g]);
            const float mag = expf(lr * dt), abr = mag * cosf(li * dt), abi = mag * sinf(li * dt);
            const float den = lr * lr + li * li, nre = abr - 1.f;
            const float fre = (nre * lr + abi * li) / den, fim = (abi * lr - nre * li) / den;
            float bbr[16], bbi[16], cr[16], ci[16];
#pragma unroll
            for (int h = 0; h < 16; ++h) {
                const float br = a->in[25][(g * 64 + p) * 16 + h], bi = a->in[26][(g * 64 + p) * 16 + h];
                bbr[h] = fre * br - fim * bi; bbi[h] = fre * bi + fim * br;
                cr[h] = a->in[27][(g * 16 + h) * 64 + p]; ci[h] = a->in[28][(g * 16 + h) * 64 + p];
            }
            const float dsk = a->in[29][g * 16 + (p & 15)];
            float xr = 0.f, xi = 0.f;
            for (int s = 0; s < SEQ; ++s) {
                const float* up = P1OUT + (size_t)(b * SEQ + s) * 768 + g * 16;
                float ur = 0.f, ui = 0.f, myu = 0.f;
#pragma unroll
                for (int h = 0; h < 16; ++h) { const float u = up[h]; ur += u * bbr[h]; ui += u * bbi[h]; if ((p & 15) == h) myu = u; }
                const float nxr = abr * xr - abi * xi + ur, nxi = abr * xi + abi * xr + ui;
                xr = nxr; xi = nxi;
                float yv = 0.f;
#pragma unroll
                for (int h = 0; h < 16; ++h) { const float v = wave_sum(xr * cr[h] - xi * ci[h]); if (p == h) yv = v; }
                if (p < 16) {
                    const float y = yv + dsk * myu;
                    const float z = 0.5f * y * (1.f + tanhf(0.7978845608028654f * (y + 0.044715f * y * y * y)));
                    Zb[(size_t)(b * SEQ + s) * 256 + g * 16 + p] = (bf16)f2bf(z);
                }
            }
        }
    }
    SEAM(9);
    if (IN(10)) { PTRS
        { pg8::EpiQup E{Q1, ropeD, 0.07216878364870323f * LOG2E}; GEMM_RUN(pg8::EpiQup, E, CQN, ws + WS_W1UQ, TOK, 1280, 256, 0); }
        { pg8::EpiBf16Plain E{KV1, 1536}; GEMM_RUN(pg8::EpiBf16Plain, E, CKVN, ws + WS_W1UKV, TOK, 1536, 256, 192); }
        { pg8::EpiSsmGate E{Zb, a->in[31], Y, DM}; GEMM_RUN(pg8::EpiSsmGate, E, Zb, ws + WS_W1GLU, TOK, 256, 256, 64); }
    }
    SEAM(10);
    if (IN(11)) { PTRS
        LAS float* sc = (LAS float*)lds + wave * SEQ;
        for (int item = gw; item < TOK * 6; item += NGW) {
            const int t = item / 6, h = item % 6, b = t / SEQ, s = t % SEQ, nk = (s / 64 + 1) * 64;
            const bf16* q = Q1 + (size_t)t * 1152 + h * 192;
            const bf16* kb = KV1 + (size_t)b * SEQ * 1536 + h * 256;
            float o0, o1;
            attn_row_naive(q, kb, 1536, 128, q + 128, KR + (size_t)b * SEQ * 64, 64, 64, kb + 128, 1536, nk, sc, lane, o0, o1);
            bf16* y = Y + (size_t)t * DM + 256 + h * 128;
            y[lane] = (bf16)f2bf(o0); y[lane + 64] = (bf16)f2bf(o1);
        }
    }
    SEAM(11);
    if (IN(12)) { PTRS pg8::EpiF32 E{MIX, DM}; GEMM_RUN(pg8::EpiF32, E, Y, ws + WS_W1OUT, TOK, DM, DM, 0); }
    SEAM(12);
    if (IN(13)) { PTRS for (int r = gw; r < TOK; r += NGW) row_norm_res(MIX + (size_t)r * DM, out + (size_t)r * DM, a->in[20], out + (size_t)r * DM, a->in[37], XN + (size_t)r * DM, lane); }
    SEAM(13);
    if (IN(14)) { PTRS pg8::EpiGateUp E{Hb, DFF}; GEMM_RUN(pg8::EpiGateUp, E, XN, ws + WS_W1GU, TOK, 2 * DFF, DM, 0); }
    SEAM(14);
    if (IN(15)) { PTRS pg8::EpiF32 E{MIX, DM}; GEMM_RUN(pg8::EpiF32, E, Hb, ws + WS_W1DN, TOK, DM, DFF, 0); }
    SEAM(15);
    if (IN(16)) { PTRS for (int r = gw; r < TOK; r += NGW) row_norm_res(MIX + (size_t)r * DM, out + (size_t)r * DM, a->in[38], out + (size_t)r * DM, nullptr, nullptr, lane); }
#undef IN
#undef PTRS
#undef SEAM
#undef GEMM_RUN
}

extern "C" void kernel_launch(void* const* d_in, const int* in_sizes, int n_in, void* d_out, int out_size, void* d_ws, size_t ws_size, hipStream_t stream) {
    static int grid = 0;
    if (grid == 0) {
        if (n_in != 42 || out_size != TOK * DM || ws_size < WS_END) { fprintf(stderr, "kernel_launch: unexpected problem shape (n_in %d out %d ws %zu)\n", n_in, out_size, ws_size); grid = -1; return; }
        int dev = 0, cus = 0, per_cu = 0;
        (void)hipGetDevice(&dev);
        (void)hipDeviceGetAttribute(&cus, hipDeviceAttributeMultiprocessorCount, dev);
        if (hipFuncSetAttribute((const void*)mega_fwd, hipFuncAttributeMaxDynamicSharedMemorySize, LDS_BYTES) != hipSuccess) { fprintf(stderr, "kernel_launch: hipFuncSetAttribute failed\n"); grid = -1; return; }
        if (hipOccupancyMaxActiveBlocksPerMultiprocessor(&per_cu, (const void*)mega_fwd, NTHREADS, LDS_BYTES) != hipSuccess || per_cu < 1) { fprintf(stderr, "kernel_launch: occupancy query says %d blocks per CU\n", per_cu); grid = -1; return; }
        (void)hipGetLastError();
        grid = cus;
        if (grid > 256) grid = 256;
        fprintf(stderr, "kernel_launch: %d CUs, %d blocks/CU by the occupancy query, grid %d\n", cus, per_cu, grid);
    }
    if (grid < 0) return;
    if (hipMemsetAsync(d_ws, 0, CTL_ZERO_BYTES, stream) != hipSuccess) { fprintf(stderr, "kernel_launch: hipMemsetAsync failed\n"); return; }
    Args a{};
    for (int i = 0; i < 42; ++i) a.in[i] = (const float*)d_in[i];
    a.out = (float*)d_out; a.ws = (unsigned char*)d_ws;
#if MK_PER_PHASE
    for (int p = 0; p < NPHASE; ++p) {
        a.ph_lo = p; a.ph_hi = p + 1;
        void* args[] = {&a};
        hipError_t e = hipLaunchCooperativeKernel((void*)mega_fwd, dim3(grid), dim3(NTHREADS), args, LDS_BYTES, stream);
        if (e != hipSuccess) { fprintf(stderr, "kernel_launch: phase %d launch failed: %s\n", p, hipGetErrorString(e)); break; }
    }
#else
    a.ph_lo = 0; a.ph_hi = NPHASE;
    void* args[] = {&a};
    hipError_t e = hipLaunchCooperativeKernel((void*)mega_fwd, dim3(grid), dim3(NTHREADS), args, LDS_BYTES, stream);
    if (e != hipSuccess) fprintf(stderr, "kernel_launch: cooperative launch failed: %s (grid %d)\n", hipGetErrorString(e), grid);
#endif
}
```

```cpp
#include <hip/hip_runtime.h>
#include <cstdio>
#include <cstdint>
#include <math.h>
namespace pg8 {
#define PG8_LAS __attribute__((address_space(3)))
typedef unsigned short bf16_t;
typedef short bf16x8 __attribute__((ext_vector_type(8)));
typedef float f32x4 __attribute__((ext_vector_type(4)));
typedef unsigned u32x4 __attribute__((ext_vector_type(4)));
constexpr int BM = 256, BK = 64, HALF = 128, HTB = HALF * BK * 2  , STAGE_BYTES = 8 * HTB, NXCD = 8, WGM = 8;

__host__ __device__ __forceinline__ int lds_byte(int r, int c) { const int st = (r >> 4) * 2 + (c >> 5), rr = r & 15, cc = c & 31, ob = rr * 64 + cc * 2; return st * 1024 + (ob ^ (((ob >> 9) & 1) << 5)); }
__host__ __device__ __forceinline__ void stage_rc(int b, int& R, int& C) { const int st = b / 1024, sb = b % 1024, swz = sb ^ (((sb >> 9) & 1) << 5); R = (st >> 1) * 16 + swz / 64; C = (st & 1) * 32 + (swz % 64) / 2; }
__host__ __device__ __forceinline__ int perm32(int rho) { const int n = rho >> 4, i = rho & 15; return 8 * (i >> 2) + 4 * n + (i & 3); }

struct Unit { int pm, pn; };
struct Gemm { const bf16_t* A; const bf16_t* Bt; int M, N, K; };

struct StaticOrder {
    int nM, nN, nwg, G, c;
    __host__ __device__ void init(int M, int N, int G_, int c_) { nM = M / BM; nN = N / BM; nwg = nM * nN; G = G_; c = c_; }
    __host__ __device__ bool next(int i, Unit& u) const {
        const long L = (long)i * G + c; if (L >= nwg) return false;
        int wgid = (int)L; { const int q = nwg / NXCD, r = nwg % NXCD, xcd = wgid % NXCD, off = wgid / NXCD; wgid = (xcd < r ? xcd * (q + 1) : r * (q + 1) + (xcd - r) * q) + off; }
        const int nig = WGM * nN, gid = wgid / nig, fm = gid * WGM, gsz = (nM - fm) < WGM ? (nM - fm) : WGM;
        u.pm = fm + ((wgid % nig) % gsz); u.pn = (wgid % nig) / gsz; return true;
    }
    __device__ __forceinline__ void a_ready(const Unit&) const {}
    __device__ __forceinline__ void done(const Unit&) const {}
};

#define MK_PER_PHASE 0

__device__ __forceinline__ unsigned cvt_pk_bf16(float lo, float hi) { unsigned r; asm volatile("v_cvt_pk_bf16_f32 %0, %1, %2" : "=v"(r) : "v"(lo), "v"(hi)); return r; }
__device__ __forceinline__ void st8(bf16_t* p, const f32x4 v0, const f32x4 v1) {
    u32x4 w; w.x = cvt_pk_bf16(v0[0], v0[1]); w.y = cvt_pk_bf16(v0[2], v0[3]); w.z = cvt_pk_bf16(v1[0], v1[1]); w.w = cvt_pk_bf16(v1[2], v1[3]); *(u32x4*)p = w;
}
__device__ __forceinline__ float sigm(float x) { return __builtin_amdgcn_rcpf(1.f + __builtin_amdgcn_exp2f(-1.4426950408889634f * x)); }
__device__ __forceinline__ float bf_lo(unsigned w) { return __uint_as_float(w << 16); }
__device__ __forceinline__ float bf_hi(unsigned w) { return __uint_as_float(w & 0xffff0000u); }

struct EpiF32 {
    static constexpr bool PERM = false, AFTER_DRAIN = false;
    float* C; int ldc;
    __device__ __forceinline__ void operator()(const f32x4 (&acc)[2][2][4][2], const Unit& u, int wr, int wc, int fr, int fq) const {
        const int row0 = u.pm * BM + wr * 64 + fr, col0 = u.pn * BM + wc * 32 + 4 * fq;
#pragma unroll
        for (int ai = 0; ai < 2; ++ai)
#pragma unroll
            for (int m = 0; m < 4; ++m) { float* rowp = C + (size_t)(row0 + ai * HALF + m * 16) * ldc + col0;
#pragma unroll
                for (int bj = 0; bj < 2; ++bj)
#pragma unroll
                    for (int n = 0; n < 2; ++n) *(f32x4*)(rowp + bj * HALF + n * 16) = acc[ai][bj][m][n]; }
    }
};
struct EpiBf16Plain {
    static constexpr bool PERM = true, AFTER_DRAIN = false;
    bf16_t* O; int ldc;
    __device__ __forceinline__ void operator()(const f32x4 (&acc)[2][2][4][2], const Unit& u, int wr, int wc, int fr, int fq) const {
        const int row0 = u.pm * BM + wr * 64 + fr, col0 = u.pn * BM + wc * 32 + 8 * fq;
#pragma unroll
        for (int ai = 0; ai < 2; ++ai)
#pragma unroll
            for (int m = 0; m < 4; ++m) { bf16_t* rowp = O + (size_t)(row0 + ai * HALF + m * 16) * ldc + col0;
#pragma unroll
                for (int bj = 0; bj < 2; ++bj) st8(rowp + bj * HALF, acc[ai][bj][m][0], acc[ai][bj][m][1]); }
    }
};
struct EpiProj0 {
    static constexpr bool PERM = true, AFTER_DRAIN = false;
    bf16_t *Q, *Kb, *V, *U; const float* ropeA; float qscale;
    __device__ __forceinline__ void operator()(const f32x4 (&acc)[2][2][4][2], const Unit& u, int wr, int wc, int fr, int fq) const {
        const int row0 = u.pm * BM + wr * 64 + fr, pn = u.pn;
        if (pn < 4) {
            bf16_t* base = (pn < 2 ? Q : Kb) + (pn & 1) * 256 + wc * 32 + 8 * fq;
            const float sc = pn < 2 ? qscale : 1.f;
            const bool ropew = (wc & 1) == 0;
            const bool ropel = fq < 2;
#pragma unroll
            for (int ai = 0; ai < 2; ++ai)
#pragma unroll
                for (int m = 0; m < 4; ++m) {
                    const int row = row0 + ai * HALF + m * 16;
                    f32x4 cs0 = {1.f, 0.f, 1.f, 0.f}, cs1 = {1.f, 0.f, 1.f, 0.f};
                    if (ropew) { const float* rp = ropeA + ((size_t)(row & 2047) * 8 + 4 * (fq & 1)) * 2; cs0 = *(const f32x4*)rp; cs1 = *(const f32x4*)(rp + 4); }
#pragma unroll
                    for (int bj = 0; bj < 2; ++bj) {
                        f32x4 v0 = acc[ai][bj][m][0], v1 = acc[ai][bj][m][1];
                        if (ropew) {
                            f32x4 r0, r1;
                            r0[0] = v0[0] * cs0[0] - v1[0] * cs0[1]; r1[0] = v1[0] * cs0[0] + v0[0] * cs0[1];
                            r0[1] = v0[1] * cs0[2] - v1[1] * cs0[3]; r1[1] = v1[1] * cs0[2] + v0[1] * cs0[3];
                            r0[2] = v0[2] * cs1[0] - v1[2] * cs1[1]; r1[2] = v1[2] * cs1[0] + v0[2] * cs1[1];
                            r0[3] = v0[3] * cs1[2] - v1[3] * cs1[3]; r1[3] = v1[3] * cs1[2] + v0[3] * cs1[3];
                            if (ropel) { v0 = r0; v1 = r1; }
                        }
                        st8(base + (size_t)row * 512 + bj * HALF, v0 * sc, v1 * sc);
                    }
                    asm volatile("" ::: "memory");
                }
        } else if (pn < 6) {
            bf16_t* base = V + (pn - 4) * 256 + wc * 32 + 8 * fq;
#pragma unroll
            for (int ai = 0; ai < 2; ++ai)
#pragma unroll
                for (int m = 0; m < 4; ++m) { const int row = row0 + ai * HALF + m * 16;
#pragma unroll
                    for (int bj = 0; bj < 2; ++bj) st8(base + (size_t)row * 512 + bj * HALF, acc[ai][bj][m][0], acc[ai][bj][m][1]); }
        } else {
            bf16_t* base = U + (pn - 6) * 128 + wc * 32 + 8 * fq;
#pragma unroll
            for (int ai = 0; ai < 2; ++ai)
#pragma unroll
                for (int m = 0; m < 4; ++m) { const int row = row0 + ai * HALF + m * 16;
                    f32x4 o[2];
#pragma unroll
                    for (int n = 0; n < 2; ++n)
#pragma unroll
                        for (int j = 0; j < 4; ++j) o[n][j] = acc[ai][0][m][n][j] * sigm(acc[ai][1][m][n][j]);
                    st8(base + (size_t)row * 512, o[0], o[1]); }
        }
    }
};
struct EpiGateUp {
    static constexpr bool PERM = true, AFTER_DRAIN = false;
    bf16_t* H; int ldh;
    __device__ __forceinline__ void operator()(const f32x4 (&acc)[2][2][4][2], const Unit& u, int wr, int wc, int fr, int fq) const {
        const int row0 = u.pm * BM + wr * 64 + fr;
        bf16_t* base = H + u.pn * 128 + wc * 32 + 8 * fq;
#pragma unroll
        for (int ai = 0; ai < 2; ++ai)
#pragma unroll
            for (int m = 0; m < 4; ++m) { const int row = row0 + ai * HALF + m * 16;
                f32x4 o[2];
#pragma unroll
                for (int n = 0; n < 2; ++n)
#pragma unroll
                    for (int j = 0; j < 4; ++j) { const float g = acc[ai][0][m][n][j]; o[n][j] = g * sigm(g) * acc[ai][1][m][n][j]; }
                st8(base + (size_t)row * ldh, o[0], o[1]); }
    }
};
struct EpiQup {
    static constexpr bool PERM = true, AFTER_DRAIN = false;
    bf16_t* Q1; const float* ropeD; float qscale;
    __device__ __forceinline__ void operator()(const f32x4 (&acc)[2][2][4][2], const Unit& u, int wr, int wc, int fr, int fq) const {
        const int row0 = u.pm * BM + wr * 64 + fr;
#pragma unroll
        for (int bj = 0; bj < 2; ++bj) {
            const int cw = u.pn * BM + bj * HALF + wc * 32;
            if (cw >= 1152) continue;
            const bool rope = ((cw >> 6) % 3) == 2;
            const int i0 = 16 * (wc & 1) + 4 * fq;
#pragma unroll
            for (int ai = 0; ai < 2; ++ai)
#pragma unroll
                for (int m = 0; m < 4; ++m) { const int row = row0 + ai * HALF + m * 16;
                    f32x4 v0 = acc[ai][bj][m][0], v1 = acc[ai][bj][m][1];
                    if (rope) {
                        const float* rp = ropeD + ((size_t)(row & 2047) * 32 + i0) * 2; const f32x4 cs0 = *(const f32x4*)rp, cs1 = *(const f32x4*)(rp + 4);
                        f32x4 r0, r1;
                        r0[0] = v0[0] * cs0[0] - v1[0] * cs0[1]; r1[0] = v1[0] * cs0[0] + v0[0] * cs0[1];
                        r0[1] = v0[1] * cs0[2] - v1[1] * cs0[3]; r1[1] = v1[1] * cs0[2] + v0[1] * cs0[3];
                        r0[2] = v0[2] * cs1[0] - v1[2] * cs1[1]; r1[2] = v1[2] * cs1[0] + v0[2] * cs1[1];
                        r0[3] = v0[3] * cs1[2] - v1[3] * cs1[3]; r1[3] = v1[3] * cs1[2] + v0[3] * cs1[3];
                        v0 = r0; v1 = r1;
                    }
                    st8(Q1 + (size_t)row * 1152 + cw + 8 * fq, v0 * qscale, v1 * qscale); asm volatile("" ::: "memory"); }
        }
    }
};
struct EpiSsmGate {
    static constexpr bool PERM = true, AFTER_DRAIN = false;
    const bf16_t* Z; const float* bias; bf16_t* Y; int ldy;
    __device__ __forceinline__ void operator()(const f32x4 (&acc)[2][2][4][2], const Unit& u, int wr, int wc, int fr, int fq) const {
        const int row0 = u.pm * BM + wr * 64 + fr;
#pragma unroll
        for (int bj = 0; bj < 2; ++bj) {
            const int c0 = bj * HALF + wc * 32 + 8 * fq;
            const f32x4 b0 = *(const f32x4*)(bias + c0), b1 = *(const f32x4*)(bias + c0 + 4);
#pragma unroll
            for (int ai = 0; ai < 2; ++ai)
#pragma unroll
                for (int m = 0; m < 4; ++m) { const int row = row0 + ai * HALF + m * 16;
                    const u32x4 zw = *(const u32x4*)(Z + (size_t)row * 256 + c0);
                    f32x4 o0, o1;
                    o0[0] = bf_lo(zw.x) * sigm(acc[ai][bj][m][0][0] + b0[0]); o0[1] = bf_hi(zw.x) * sigm(acc[ai][bj][m][0][1] + b0[1]);
                    o0[2] = bf_lo(zw.y) * sigm(acc[ai][bj][m][0][2] + b0[2]); o0[3] = bf_hi(zw.y) * sigm(acc[ai][bj][m][0][3] + b0[3]);
                    o1[0] = bf_lo(zw.z) * sigm(acc[ai][bj][m][1][0] + b1[0]); o1[1] = bf_hi(zw.z) * sigm(acc[ai][bj][m][1][1] + b1[1]);
                    o1[2] = bf_lo(zw.w) * sigm(acc[ai][bj][m][1][2] + b1[2]); o1[3] = bf_hi(zw.w) * sigm(acc[ai][bj][m][1][3] + b1[3]);
                    st8(Y + (size_t)row * ldy + c0, o0, o1); asm volatile("" ::: "memory"); }
        }
    }
};

template <class Epi, class Sched, bool ALIGN_EPI = false, bool SP2 = false>
__device__ __forceinline__ void gemm_phase(PG8_LAS unsigned char* lds, const Gemm g, const Sched& S, const Epi& E, const int wid  ) {
    int lane_ = __builtin_amdgcn_mbcnt_hi(~0u, __builtin_amdgcn_mbcnt_lo(~0u, 0u)); asm volatile("" : "+v"(lane_));
    const int lane = lane_, tid = wid * 64 + lane, wr = wid >> 2, wc = wid & 3, fr = lane & 15, fq = lane >> 4;
    const int K = g.K, nt = K / BK;
    unsigned voffA[2], voffB[2];
#pragma unroll
    for (int i = 0; i < 2; ++i) { int R, C; stage_rc(tid * 16 + i * 8192, R, C); const int Rb = Epi::PERM ? ((R & ~31) + perm32(R & 31)) : R;
        voffA[i] = (unsigned)(R * K + C) * 2u; voffB[i] = (unsigned)(Rb * K + C) * 2u; }
    const size_t kstep = (size_t)(BK * 2);
    const size_t hstep = (size_t)HALF * K * 2;
    const size_t tstep = 2 * hstep;
    const unsigned ldsw = (unsigned)wid * 1024u;
    const int aoff = lds_byte(wr * 64 + fr, fq * 8), boff = lds_byte(wc * 32 + fr, fq * 8);
#define PG8_SA(b, h) (((b) * 2 + (h)) * HTB)
#define PG8_SB(b, h) ((4 + (b) * 2 + (h)) * HTB)
#define PG8_STAGE(bufoff, gbase, voff) do { _Pragma("unroll") for (int _i = 0; _i < 2; ++_i) \
        __builtin_amdgcn_global_load_lds((const unsigned*)((const char*)(gbase) + (voff)[_i]), (PG8_LAS unsigned*)(lds + (bufoff) + ldsw + _i * 8192), 16, 0, 0); } while (0)
#define PG8_LDA(dst, b, h) do { _Pragma("unroll") for (int m = 0; m < 4; ++m) _Pragma("unroll") for (int k = 0; k < 2; ++k) dst[m][k] = *(const PG8_LAS bf16x8*)(lds + PG8_SA(b, h) + aoff + m * 2048 + k * 1024); } while (0)
#define PG8_LDB(dst, b, h) do { _Pragma("unroll") for (int n = 0; n < 2; ++n) _Pragma("unroll") for (int k = 0; k < 2; ++k) dst[n][k] = *(const PG8_LAS bf16x8*)(lds + PG8_SB(b, h) + boff + n * 2048 + k * 1024); } while (0)
#define PG8_MMA(ai, bj, At, Bt) do { __builtin_amdgcn_s_setprio(1); _Pragma("unroll") for (int m = 0; m < 4; ++m) _Pragma("unroll") for (int n = 0; n < 2; ++n) _Pragma("unroll") for (int k = 0; k < 2; ++k) \
        acc[ai][bj][m][n] = __builtin_amdgcn_mfma_f32_16x16x32_bf16(Bt[n][k], At[m][k], acc[ai][bj][m][n], 0, 0, 0); __builtin_amdgcn_s_setprio(0); } while (0)
#define PG8_WAIT_V(n) asm volatile("s_waitcnt vmcnt(" #n ")" ::: "memory")
#define PG8_WAIT_L(n) asm volatile("s_waitcnt lgkmcnt(" #n ")" ::: "memory")
#define PG8_BAR __builtin_amdgcn_s_barrier()
#define PG8_SCHED __builtin_amdgcn_sched_barrier(0)
    Unit cur, nxt; int ui = 0;
    if (!S.next(0, cur)) return;
    f32x4 acc[2][2][4][2];
#pragma unroll
    for (int a = 0; a < 2; ++a)
#pragma unroll
        for (int b = 0; b < 2; ++b)
#pragma unroll
            for (int m = 0; m < 4; ++m)
#pragma unroll
                for (int n = 0; n < 2; ++n) acc[a][b][m][n] = (f32x4){0.f, 0.f, 0.f, 0.f};
    bf16x8 At[4][2], B0[2][2], B1[2][2];
    const char* cA = (const char*)g.A + (size_t)cur.pm * tstep; const char* cB = (const char*)g.Bt + (size_t)cur.pn * tstep;
    S.a_ready(cur);
    if constexpr (SP2) {
        PG8_STAGE(PG8_SB(0, 0), cB, voffB); PG8_STAGE(PG8_SB(0, 1), cB + hstep, voffB); PG8_STAGE(PG8_SA(0, 0), cA, voffA); PG8_STAGE(PG8_SA(0, 1), cA + hstep, voffA);
        if (wr == 1) PG8_BAR;
        PG8_WAIT_V(2); PG8_BAR;
        PG8_STAGE(PG8_SB(1, 0), cB + kstep, voffB); PG8_STAGE(PG8_SA(1, 0), cA + kstep, voffA); PG8_STAGE(PG8_SB(1, 1), cB + hstep + kstep, voffB);
        PG8_WAIT_V(6); PG8_BAR;
    } else {
        PG8_STAGE(PG8_SB(0, 0), cB, voffB); PG8_STAGE(PG8_SA(0, 0), cA, voffA); PG8_STAGE(PG8_SB(0, 1), cB + hstep, voffB); PG8_STAGE(PG8_SA(0, 1), cA + hstep, voffA);
        if (wr == 1) PG8_BAR;
        PG8_WAIT_V(4); PG8_BAR;
        PG8_STAGE(PG8_SB(1, 0), cB + kstep, voffB); PG8_STAGE(PG8_SA(1, 0), cA + kstep, voffA); PG8_STAGE(PG8_SB(1, 1), cB + hstep + kstep, voffB);
        PG8_WAIT_V(6); PG8_BAR;
    }
    for (;;) {
        const bool has_next = S.next(ui + 1, nxt);
        const char* nA = has_next ? (const char*)g.A + (size_t)nxt.pm * tstep : cA; const char* nB = has_next ? (const char*)g.Bt + (size_t)nxt.pn * tstep : cB;
        for (int t = 0; t < nt; t += 2) {
            const bool last = (t == nt - 2);
            const char* a1 = cA + (size_t)(t + 1) * kstep;
            const char* a2 = last ? nA : cA + (size_t)(t + 2) * kstep; const char* b2 = last ? nB : cB + (size_t)(t + 2) * kstep;
            const char* a3 = a2 + kstep; const char* b3 = b2 + kstep;
            if (last && has_next) S.a_ready(nxt);
            if constexpr (SP2) {
            PG8_LDB(B0, 0, 0); PG8_LDB(B1, 0, 1); PG8_SCHED; PG8_LDA(At, 0, 0); PG8_STAGE(PG8_SA(1, 1), a1 + hstep, voffA);
            PG8_WAIT_V(8); PG8_WAIT_L(0); PG8_BAR; PG8_MMA(0, 0, At, B0); PG8_MMA(0, 1, At, B1); PG8_BAR; PG8_SCHED;
            PG8_LDA(At, 0, 1); PG8_STAGE(PG8_SB(0, 0), b2, voffB); PG8_STAGE(PG8_SB(0, 1), b2 + hstep, voffB); PG8_STAGE(PG8_SA(0, 0), a2, voffA);
            PG8_WAIT_V(8); PG8_WAIT_L(0); PG8_BAR; PG8_MMA(1, 0, At, B0); PG8_MMA(1, 1, At, B1); PG8_BAR; PG8_SCHED;
            PG8_LDB(B0, 1, 0); PG8_LDB(B1, 1, 1); PG8_SCHED; PG8_LDA(At, 1, 0); PG8_STAGE(PG8_SA(0, 1), a2 + hstep, voffA);
            PG8_WAIT_V(8); PG8_WAIT_L(0); PG8_BAR; PG8_MMA(0, 0, At, B0); PG8_MMA(0, 1, At, B1); PG8_BAR; PG8_SCHED;
            PG8_LDA(At, 1, 1); PG8_STAGE(PG8_SB(1, 0), b3, voffB); PG8_STAGE(PG8_SB(1, 1), b3 + hstep, voffB); PG8_STAGE(PG8_SA(1, 0), a3, voffA);
            PG8_WAIT_V(8); PG8_WAIT_L(0); PG8_BAR; PG8_MMA(1, 0, At, B0); PG8_MMA(1, 1, At, B1); PG8_BAR; PG8_SCHED;
            } else {
            PG8_LDB(B0, 0, 0); PG8_SCHED; PG8_LDA(At, 0, 0); PG8_STAGE(PG8_SA(1, 1), a1 + hstep, voffA);
            PG8_WAIT_L(8); PG8_BAR; PG8_WAIT_L(0); PG8_MMA(0, 0, At, B0); PG8_BAR; PG8_SCHED;
            PG8_LDB(B1, 0, 1); PG8_STAGE(PG8_SB(0, 0), b2, voffB);
            PG8_BAR; PG8_WAIT_L(0); PG8_MMA(0, 1, At, B1); PG8_BAR;
            PG8_LDA(At, 0, 1); PG8_STAGE(PG8_SA(0, 0), a2, voffA);
            PG8_BAR; PG8_WAIT_L(0); PG8_MMA(1, 0, At, B0); PG8_BAR; PG8_SCHED;
            PG8_STAGE(PG8_SB(0, 1), b2 + hstep, voffB);
            PG8_WAIT_V(6); PG8_BAR; PG8_MMA(1, 1, At, B1); PG8_BAR;
            PG8_LDB(B0, 1, 0); PG8_SCHED; PG8_LDA(At, 1, 0); PG8_STAGE(PG8_SA(0, 1), a2 + hstep, voffA);
            PG8_WAIT_L(8); PG8_BAR; PG8_WAIT_L(0); PG8_MMA(0, 0, At, B0); PG8_BAR; PG8_SCHED;
            PG8_LDB(B1, 1, 1); PG8_STAGE(PG8_SB(1, 0), b3, voffB);
            PG8_BAR; PG8_WAIT_L(0); PG8_MMA(0, 1, At, B1); PG8_BAR;
            PG8_LDA(At, 1, 1); PG8_STAGE(PG8_SA(1, 0), a3, voffA);
            PG8_BAR; PG8_WAIT_L(0); PG8_MMA(1, 0, At, B0); PG8_BAR; PG8_SCHED;
            PG8_STAGE(PG8_SB(1, 1), b3 + hstep, voffB);
            PG8_WAIT_V(6); PG8_BAR; PG8_MMA(1, 1, At, B1); PG8_BAR;
            }
        }
        if constexpr (ALIGN_EPI) { if (wr == 0) PG8_BAR; }
        if constexpr (!Epi::AFTER_DRAIN) { E(acc, cur, wr, wc, fr, fq); S.done(cur); }
        if (!has_next) break;
#pragma unroll
        for (int a = 0; a < 2; ++a)
#pragma unroll
            for (int b = 0; b < 2; ++b)
#pragma unroll
                for (int m = 0; m < 4; ++m)
#pragma unroll
                    for (int n = 0; n < 2; ++n) acc[a][b][m][n] = (f32x4){0.f, 0.f, 0.f, 0.f};
        cur = nxt; cA = nA; cB = nB; ++ui;
        if constexpr (ALIGN_EPI) { if (wr == 1) PG8_BAR; }
    }
    PG8_WAIT_V(0);
    if constexpr (!ALIGN_EPI) { if (wr == 0) PG8_BAR; }
    PG8_BAR;
    if constexpr (Epi::AFTER_DRAIN) { E.fused(acc, cur, wr, wc, fr, fq, lds, wid, lane); S.done(cur); }
#undef PG8_SA
#undef PG8_SB
#undef PG8_STAGE
#undef PG8_LDA
#undef PG8_LDB
#undef PG8_MMA
#undef PG8_WAIT_V
#undef PG8_WAIT_L
#undef PG8_BAR
#undef PG8_SCHED
}
}

#define LAS __attribute__((address_space(3)))
typedef unsigned short bf16;
typedef float f32x4 __attribute__((ext_vector_type(4)));
typedef unsigned u32x4 __attribute__((ext_vector_type(4)));
typedef unsigned u32x2 __attribute__((ext_vector_type(2)));

constexpr int NWAVES = 8, NTHREADS = 512;
constexpr int BATCH = 8, SEQ = 2048, DM = 1024, TOK = BATCH * SEQ, DFF = 2816;
constexpr float RMS_EPS = 1e-6f, LN_EPS = 1e-5f;
constexpr float LOG2E = 1.4426950408889634f;
constexpr int LDS_BYTES = 147456;

#ifndef MK_PER_PHASE
#define MK_PER_PHASE 0
#endif

constexpr size_t MiB = 1u << 20;
constexpr size_t WS_ROPEA = 1 * MiB, WS_ROPED = 1 * MiB + 128 * 1024;
constexpr size_t WS_W0IN = 2 * MiB, WS_W0OUT = 7 * MiB, WS_W0GU = 9 * MiB, WS_W0DN = 20 * MiB;
constexpr size_t WS_W1IN = 26 * MiB, WS_W1UQ = 28 * MiB, WS_W1UKV = 29 * MiB, WS_W1GLU = 30 * MiB, WS_W1OUT = 31 * MiB, WS_W1GU = 33 * MiB, WS_W1DN = 44 * MiB;
constexpr size_t WS_H = 50 * MiB;
constexpr size_t WS_Q = 50 * MiB, WS_K = 66 * MiB, WS_V = 82 * MiB, WS_U = 98 * MiB;
constexpr size_t WS_Q1 = 50 * MiB, WS_KV1 = 86 * MiB;
constexpr size_t WS_MIX = 138 * MiB;
constexpr size_t WS_Z = 186 * MiB;
constexpr size_t WS_XN = 202 * MiB;
constexpr size_t WS_CQN = 234 * MiB, WS_CKVN = 242 * MiB, WS_KR = 250 * MiB;
constexpr size_t WS_END = 256 * MiB;

__device__ __forceinline__ float bf2f(unsigned short u) { return __uint_as_float((unsigned)u << 16); }
__device__ __forceinline__ unsigned f2bf(float f) { unsigned u = __builtin_bit_cast(unsigned, f); return (u + 0x7fffu + ((u >> 16) & 1u)) >> 16; }
__device__ __forceinline__ unsigned pk2(float lo, float hi) { return f2bf(lo) | (f2bf(hi) << 16); }
__device__ __forceinline__ float wave_sum(float v) {
#pragma unroll
    for (int o = 1; o < 64; o <<= 1) v += __shfl_xor(v, o);
    return v;
}
__device__ __forceinline__ float wave_max(float v) {
#pragma unroll
    for (int o = 1; o < 64; o <<= 1) v = fmaxf(v, __shfl_xor(v, o));
    return v;
}
__device__ __forceinline__ float bf_lo_(unsigned w) { return __uint_as_float(w << 16); }
__device__ __forceinline__ float bf_hi_(unsigned w) { return __uint_as_float(w & 0xffff0000u); }
__device__ __forceinline__ int fresh_lane() { int l = __builtin_amdgcn_mbcnt_hi(~0u, __builtin_amdgcn_mbcnt_lo(~0u, 0u)); asm volatile("" : "+v"(l)); return l; }
__device__ __forceinline__ float dot4(const f32x4 a, const f32x4 b) { return (a[0] * b[0] + a[1] * b[1]) + (a[2] * b[2] + a[3] * b[3]); }

struct Args { const float* in[42]; float* out; unsigned char* ws; int ph_lo, ph_hi; };
typedef const Args __attribute__((address_space(4)))* ArgsP;
__device__ __forceinline__ ArgsP launder(ArgsP p) { asm volatile("" : "+s"(p)); return p; }

__device__ __forceinline__ int permA(int p) { if (p >= 16) return p; const int g = p >> 3, j = p & 7; return (j < 4) ? 4 * g + j : 8 + 4 * g + (j - 4); }
__device__ __forceinline__ int permD(int p) { const int wl = p >> 5, fq = (p >> 3) & 3, j = p & 7; return (j < 4) ? 16 * wl + 4 * fq + j : 32 + 16 * wl + 4 * fq + (j - 4); }

struct WMat { int K, N, Ksrc; size_t off; };
__device__ __forceinline__ WMat wmat(int m) {
    switch (m) {
        case 0: return WMat{1024, 2560, 1024, WS_W0IN};
        case 1: return WMat{1024, 1024, 1024, WS_W0OUT};
        case 2: return WMat{1024, 5632, 1024, WS_W0GU};
        case 3: return WMat{2816, 1024, 2816, WS_W0DN};
        case 4: return WMat{1024, 768, 1024, WS_W1IN};
        case 5: return WMat{256, 1280, 256, WS_W1UQ};
        case 6: return WMat{256, 1536, 128, WS_W1UKV};
        case 7: return WMat{256, 256, 256, WS_W1GLU};
        case 8: return WMat{1024, 1024, 1024, WS_W1OUT};
        case 9: return WMat{1024, 5632, 1024, WS_W1GU};
        default: return WMat{2816, 1024, 2816, WS_W1DN};
    }
}
__device__ __forceinline__ const float* wsrc(ArgsP a, int m, int n, int& ld) {
    switch (m) {
        case 0: { ld = 2560; int c;
            if (n < 1024) c = (n & ~63) + permA(n & 63);
            else if (n < 1536) c = n;
            else { const int r = n - 1536, t = r >> 8, rr = r & 255; c = rr < 128 ? 1536 + 128 * t + rr : 2048 + 128 * t + (rr - 128); }
            return a->in[3] + c; }
        case 1: ld = 1024; return a->in[13] + n;
        case 2: { ld = 2816; const int j = n >> 8, rr = n & 255; return rr < 128 ? a->in[16] + 128 * j + rr : a->in[17] + 128 * j + (rr - 128); }
        case 3: ld = 1024; return a->in[18] + n;
        case 4: { ld = 704; if (n >= 704) return nullptr; return a->in[21] + n; }
        case 5: { ld = 1152; if (n >= 1152) return nullptr; const int blk = n >> 6; return a->in[33] + ((blk % 3) == 2 ? (n & ~63) + permD(n & 63) : n); }
        case 6: ld = 1536; return a->in[35] + n;
        case 7: ld = 256; return a->in[30] + n;
        case 8: ld = 1024; return a->in[36] + n;
        case 9: { ld = 2816; const int j = n >> 8, rr = n & 255; return rr < 128 ? a->in[39] + 128 * j + rr : a->in[40] + 128 * j + (rr - 128); }
        default: ld = 1024; return a->in[41] + n;
    }
}
__device__ __forceinline__ void p0_transpose_item(ArgsP a, int m, const WMat w, int item, LAS float* scr, int lane) {
    const int nblk = w.N / 32, kb = item / nblk, nb = item % nblk, k0 = 64 * kb, n0 = 32 * nb;
    int ld; const float* src = wsrc(a, m, n0 + (lane & 31), ld);
#pragma unroll 8
    for (int i = 0; i < 32; ++i) { const int kk = 2 * i + (lane >> 5); const int k = k0 + kk;
        scr[kk * 33 + (lane & 31)] = (src != nullptr && k < w.Ksrc) ? src[(size_t)k * ld] : 0.f; }
    asm volatile("s_waitcnt lgkmcnt(0)" ::: "memory");
    bf16* WT = (bf16*)(a->ws + w.off);
    const int c = lane & 7;
#pragma unroll
    for (int j = 0; j < 4; ++j) { const int n = (lane >> 3) + 8 * j; const LAS float* s = scr + (8 * c) * 33 + n;
        u32x4 o; o.x = pk2(s[0 * 33], s[1 * 33]); o.y = pk2(s[2 * 33], s[3 * 33]); o.z = pk2(s[4 * 33], s[5 * 33]); o.w = pk2(s[6 * 33], s[7 * 33]);
        *(u32x4*)(WT + (size_t)(n0 + n) * w.K + k0 + 8 * c) = o; }
    asm volatile("s_waitcnt lgkmcnt(0)" ::: "memory");
}

__device__ __forceinline__ void row_norm(const float* xrow, const float* g, bf16* xn, int lane) {
    f32x4 v[4]; float s = 0.f;
#pragma unroll
    for (int j = 0; j < 4; ++j) { v[j] = ((const f32x4*)xrow)[lane + 64 * j]; s += dot4(v[j], v[j]); }
    const float rstd = 1.0f / sqrtf(wave_sum(s) * (1.f / DM) + RMS_EPS);
#pragma unroll
    for (int j = 0; j < 4; ++j) { const f32x4 gg = ((const f32x4*)g)[lane + 64 * j]; const f32x4 t = v[j] * rstd * gg;
        u32x2 o; o.x = pk2(t[0], t[1]); o.y = pk2(t[2], t[3]); ((u32x2*)xn)[lane + 64 * j] = o; }
}
__device__ __forceinline__ void row_norm_res(const float* mix, const float* res, const float* gpost, float* out, const float* gpre, bf16* xn, int lane) {
    f32x4 v[4]; float s = 0.f;
#pragma unroll
    for (int j = 0; j < 4; ++j) { v[j] = ((const f32x4*)mix)[lane + 64 * j]; s += dot4(v[j], v[j]); }
    const float rstd = 1.0f / sqrtf(wave_sum(s) * (1.f / DM) + RMS_EPS);
    float s2 = 0.f;
#pragma unroll
    for (int j = 0; j < 4; ++j) { const f32x4 gg = ((const f32x4*)gpost)[lane + 64 * j]; const f32x4 r = ((const f32x4*)res)[lane + 64 * j];
        v[j] = r + v[j] * rstd * gg; ((f32x4*)out)[lane + 64 * j] = v[j]; s2 += dot4(v[j], v[j]); }
    if (xn) {
        const float rstd2 = 1.0f / sqrtf(wave_sum(s2) * (1.f / DM) + RMS_EPS);
#pragma unroll
        for (int j = 0; j < 4; ++j) { const f32x4 gg = ((const f32x4*)gpre)[lane + 64 * j]; const f32x4 t = v[j] * rstd2 * gg;
            u32x2 o; o.x = pk2(t[0], t[1]); o.y = pk2(t[2], t[3]); ((u32x2*)xn)[lane + 64 * j] = o; }
    }
}
__device__ __forceinline__ void row_latent(const float* p, int s, const float* qg, const float* kvg, const float* ropeD, bf16* cqn, bf16* ckvn, bf16* kr, int lane) {
    { const f32x4 v = ((const f32x4*)(p + 256))[lane]; const float rstd = 1.0f / sqrtf(wave_sum(dot4(v, v)) * (1.f / 256.f) + RMS_EPS);
      const f32x4 t = v * rstd * ((const f32x4*)qg)[lane]; u32x2 o; o.x = pk2(t[0], t[1]); o.y = pk2(t[2], t[3]); ((u32x2*)cqn)[lane] = o; }
    { f32x4 v = {0.f, 0.f, 0.f, 0.f}; if (lane < 32) v = ((const f32x4*)(p + 512))[lane];
      const float rstd = 1.0f / sqrtf(wave_sum(dot4(v, v)) * (1.f / 128.f) + RMS_EPS);
      f32x4 t = {0.f, 0.f, 0.f, 0.f}; if (lane < 32) t = v * rstd * ((const f32x4*)kvg)[lane];
      u32x2 o; o.x = pk2(t[0], t[1]); o.y = pk2(t[2], t[3]); ((u32x2*)ckvn)[lane] = o; }
    if (lane < 32) { const int d = lane; const float x1 = p[640 + d], x2 = p[672 + d]; const float c = ropeD[((size_t)s * 32 + d) * 2], sn = ropeD[((size_t)s * 32 + d) * 2 + 1];
      const int p1 = 32 * (d >> 4) + 8 * ((d >> 2) & 3) + (d & 3);
      kr[p1] = (bf16)f2bf(x1 * c - x2 * sn); kr[p1 + 4] = (bf16)f2bf(x2 * c + x1 * sn); }
}

__device__ __forceinline__ float dot8(const u32x4 a, const u32x4 b) {
    return (bf_lo_(a.x) * bf_lo_(b.x) + bf_hi_(a.x) * bf_hi_(b.x)) + (bf_lo_(a.y) * bf_lo_(b.y) + bf_hi_(a.y) * bf_hi_(b.y))
         + (bf_lo_(a.z) * bf_lo_(b.z) + bf_hi_(a.z) * bf_hi_(b.z)) + (bf_lo_(a.w) * bf_lo_(b.w) + bf_hi_(a.w) * bf_hi_(b.w));
}
__device__ __forceinline__ void attn_row_naive(const bf16* q1, const bf16* k1, int ldk1, int D1, const bf16* q2, const bf16* k2, int ldk2, int D2,
                                               const bf16* v, int ldv, int nk, LAS float* sc, int lane, float& o0, float& o1) {
    float mx = -INFINITY;
    for (int k = lane; k < nk; k += 64) {
        const bf16* kp = k1 + (size_t)k * ldk1; float d = 0.f;
        for (int i = 0; i < D1; i += 8) d += dot8(*(const u32x4*)(q1 + i), *(const u32x4*)(kp + i));
        if (D2) { const bf16* kp2 = k2 + (size_t)k * ldk2; for (int i = 0; i < D2; i += 8) d += dot8(*(const u32x4*)(q2 + i), *(const u32x4*)(kp2 + i)); }
        sc[k] = d; mx = fmaxf(mx, d);
    }
    mx = wave_max(mx);
    float sum = 0.f;
    for (int k = lane; k < nk; k += 64) { const float p = exp2f(sc[k] - mx); sc[k] = p; sum += p; }
    sum = wave_sum(sum);
    asm volatile("s_waitcnt lgkmcnt(0)" ::: "memory");
    float a0 = 0.f, a1 = 0.f;
    for (int k = 0; k < nk; ++k) { const float p = sc[k]; const bf16* vp = v + (size_t)k * ldv; a0 += p * bf2f(vp[lane]); a1 += p * bf2f(vp[lane + 64]); }
    const float inv = 1.f / sum; o0 = a0 * inv; o1 = a1 * inv;
    asm volatile("s_waitcnt lgkmcnt(0)" ::: "memory");
}

#define GAS __attribute__((address_space(1)))
typedef GAS unsigned gu32;
#define RLX_AGENT __ATOMIC_RELAXED, __HIP_MEMORY_SCOPE_AGENT
constexpr int CW_BAR = 4096;
constexpr size_t CTL_ZERO_BYTES = 64 * 1024;
constexpr int LDSCTL_OFF = 131072, MISC_OFF = LDSCTL_OFF + 320;
#define XB_TMO      128
#define XB_XCNT(j)  (256  + 64 * (j))
#define XB_XSUB(j)  (1280 + 64 * (j))
#define XB_XGEN(j)  (2304 + 64 * (j))
#define XB_TOP      3328
#define XB_TOPGEN   3392
#define XCD_BAR_WORDS 3456
#define XB_SPIN_CAP (1u << 18)

__device__ __forceinline__ unsigned xb_ld(unsigned* p)              { return __hip_atomic_load(p, __ATOMIC_RELAXED, __HIP_MEMORY_SCOPE_AGENT); }
__device__ __forceinline__ unsigned xb_add(unsigned* p, unsigned v) { return __hip_atomic_fetch_add(p, v, __ATOMIC_RELAXED, __HIP_MEMORY_SCOPE_AGENT); }
__device__ __forceinline__ unsigned xb_xcc_id() { return (unsigned)__builtin_amdgcn_s_getreg((3 << 11) | 20) & 0xFu; }
#define XB_SPIN(cond, bar) do { unsigned _sp = 0; while (cond) { __builtin_amdgcn_s_sleep(1); \
    if ((++_sp & 255u) == 0u) { if (xb_ld(&(bar)[XB_TMO])) break; if (_sp > XB_SPIN_CAP) { atomicAdd(&(bar)[XB_TMO], 1u); break; } } } } while (0)

struct XcdBarrier {
    unsigned* bar; unsigned x;
    volatile LAS unsigned* st;
};

__device__ __forceinline__ XcdBarrier xcd_barrier_post(unsigned* bar, volatile LAS unsigned* st, bool leader) {
    XcdBarrier b; b.bar = bar; b.x = xb_xcc_id(); b.st = st;
    if (leader) (void)xb_add(&bar[XB_XCNT(b.x)], 1u);
    return b;
}
__device__ __forceinline__ void xcd_barrier_complete(unsigned* bar, unsigned x, unsigned& nloc, unsigned& nx) {
    const unsigned G = gridDim.x * gridDim.y * gridDim.z;
    unsigned sum, cnt, mine, sp = 0u;
    for (;;) {
        sum = 0u; cnt = 0u; mine = 0u;
#pragma unroll
        for (unsigned j = 0; j < 16; ++j) { const unsigned c = xb_ld(&bar[XB_XCNT(j)]); sum += c; cnt += (c > 0u) ? 1u : 0u; mine = (j == x) ? c : mine; }
        if (sum == G) break;
        __builtin_amdgcn_s_sleep(1);
        if ((++sp & 255u) == 0u) { if (xb_ld(&bar[XB_TMO])) break; if (sp > XB_SPIN_CAP) { atomicAdd(&bar[XB_TMO], 1u); break; } }
    }
    nloc = mine > 0u ? mine : 1u; nx = cnt > 0u ? cnt : 1u;
}

__device__ __forceinline__ void xcd_barrier(const XcdBarrier& b, bool leader) {
    asm volatile("s_waitcnt vmcnt(0)" ::: "memory");
    __syncthreads();
    if (leader) {
        unsigned* bar = b.bar;
        __builtin_amdgcn_s_waitcnt(0);
        unsigned nloc = b.st[0], nx = b.st[1];
        if (nloc == 0u) { xcd_barrier_complete(bar, b.x, nloc, nx); b.st[0] = nloc; b.st[1] = nx; }
        const unsigned old = xb_add(&bar[XB_XSUB(b.x)], 1u);
        const unsigned gen = old / nloc;
        if (old + 1u == (gen + 1u) * nloc) {
            __builtin_amdgcn_fence(__ATOMIC_RELEASE, "agent");
            asm volatile("s_waitcnt vmcnt(0)" ::: "memory");
            const unsigned og = xb_add(&bar[XB_TOP], 1u);
            const unsigned tg = og / nx;
            if (og + 1u == (tg + 1u) * nx) xb_add(&bar[XB_TOPGEN], 1u);
            else XB_SPIN(xb_ld(&bar[XB_TOPGEN]) == tg, bar);
            __builtin_amdgcn_fence(__ATOMIC_ACQUIRE, "agent");
            xb_add(&bar[XB_XGEN(b.x)], 1u);
            asm volatile("s_waitcnt vmcnt(0)" ::: "memory");
        } else {
            XB_SPIN(xb_ld(&bar[XB_XGEN(b.x)]) == gen, bar);
            __builtin_amdgcn_fence(__ATOMIC_ACQUIRE, "agent");
            asm volatile("s_waitcnt vmcnt(0)" ::: "memory");
        }
    }
    __syncthreads();
}

namespace att {
typedef short bf16x8 __attribute__((ext_vector_type(8)));
typedef short s16x4 __attribute__((ext_vector_type(4)));
typedef short v4i16_t __attribute__((ext_vector_type(4)));
typedef float f32x16 __attribute__((ext_vector_type(16)));
typedef float f32x2_t __attribute__((ext_vector_type(2)));
typedef __bf16 bf16x2_t __attribute__((ext_vector_type(2)));
__device__ __forceinline__ int crow(int r, int hi) { return (r & 3) + 8 * (r >> 2) + 4 * hi; }
__device__ __forceinline__ unsigned cvtpk(float lo, float hi) { f32x2_t v = {lo, hi}; bf16x2_t b = __builtin_convertvector(v, bf16x2_t); return __builtin_bit_cast(unsigned, b); }
__device__ __forceinline__ s16x4 vtr(LAS const unsigned char* p) { return __builtin_bit_cast(s16x4, __builtin_amdgcn_ds_read_tr16_b64_v4i16((LAS v4i16_t*)p)); }
__device__ __forceinline__ float half_swap_max(float m) { auto rr = __builtin_amdgcn_permlane32_swap(__float_as_uint(m), __float_as_uint(m), false, false); return fmaxf(__uint_as_float(rr[0]), __uint_as_float(rr[1])); }
__device__ __forceinline__ float half_swap_sum(float m) { auto rr = __builtin_amdgcn_permlane32_swap(__float_as_uint(m), __float_as_uint(m), false, false); return __uint_as_float(rr[0]) + __uint_as_float(rr[1]); }
constexpr float THR = 8.0f;
constexpr int WSF_OFF = 131072 + 1024;
constexpr int XCH_OFF = 65536;

template <int DSTEPS>
__device__ __forceinline__ void tile_compute(LAS const unsigned char* kb, int kstep  , LAS const unsigned char* vb, const bf16x8 (&qr)[DSTEPS],
                                             f32x16 (&o)[4], f32x16& negm, float& mhat, float& lsum, LAS float* wsf, int r32, int hi) {
    f32x16 c0 = negm, c1 = negm;
#pragma unroll
    for (int d0 = 0; d0 < DSTEPS; ++d0) {
        const bf16x8 k0 = *(LAS const bf16x8*)(kb + d0 * kstep), k1 = *(LAS const bf16x8*)(kb + d0 * kstep + 512);
        c0 = __builtin_amdgcn_mfma_f32_32x32x16_bf16(k0, qr[d0], c0, 0, 0, 0);
        c1 = __builtin_amdgcn_mfma_f32_32x32x16_bf16(k1, qr[d0], c1, 0, 0, 0);
    }
    float rm = fmaxf(c0[0], c1[0]);
#pragma unroll
    for (int r = 1; r < 16; ++r) rm = fmaxf(rm, fmaxf(c0[r], c1[r]));
    rm = half_swap_max(rm);
    if (__any(rm > THR)) {
        const float dl = fmaxf(rm, 0.f); mhat += dl;
#pragma unroll
        for (int r = 0; r < 16; ++r) { c0[r] -= dl; c1[r] -= dl; negm[r] = -mhat; }
        const float f = exp2f(-dl); lsum *= f;
        if (hi == 0) wsf[r32] = f;
        asm volatile("s_waitcnt lgkmcnt(0)" ::: "memory");
#pragma unroll
        for (int r = 0; r < 16; ++r) { const float fr = wsf[crow(r, hi)];
#pragma unroll
            for (int e = 0; e < 4; ++e) o[e][r] *= fr; }
        asm volatile("s_waitcnt lgkmcnt(0)" ::: "memory");
    }
    float ls = 0.f;
#pragma unroll
    for (int r = 0; r < 16; ++r) { c0[r] = exp2f(c0[r]); c1[r] = exp2f(c1[r]); ls += c0[r] + c1[r]; }
    lsum += ls;
    u32x4 pw[4];
#pragma unroll
    for (int s = 0; s < 2; ++s) {
        pw[s]     = (u32x4){cvtpk(c0[8 * s], c0[8 * s + 1]), cvtpk(c0[8 * s + 2], c0[8 * s + 3]), cvtpk(c0[8 * s + 4], c0[8 * s + 5]), cvtpk(c0[8 * s + 6], c0[8 * s + 7])};
        pw[2 + s] = (u32x4){cvtpk(c1[8 * s], c1[8 * s + 1]), cvtpk(c1[8 * s + 2], c1[8 * s + 3]), cvtpk(c1[8 * s + 4], c1[8 * s + 5]), cvtpk(c1[8 * s + 6], c1[8 * s + 7])};
    }
#pragma unroll
    for (int e = 0; e < 4; ++e)
#pragma unroll
        for (int ks = 0; ks < 4; ++ks) {
            const s16x4 lo = vtr(vb + (e * 8 + 2 * ks) * 512), hh = vtr(vb + (e * 8 + 2 * ks + 1) * 512);
            const bf16x8 vf = {lo[0], lo[1], lo[2], lo[3], hh[0], hh[1], hh[2], hh[3]};
            o[e] = __builtin_amdgcn_mfma_f32_32x32x16_bf16(__builtin_bit_cast(bf16x8, pw[ks]), vf, o[e], 0, 0, 0);
        }
}

__device__ __forceinline__ void diff_unit(LAS unsigned char* lds, int b, int h, int qb, const bf16* Q, const bf16* K, const bf16* V, bf16* Y, float lam, const float* subln, int wave, int lane_in) {
    int lane = lane_in; asm volatile("" : "+v"(lane));
    const int r32 = lane & 31, hi = lane >> 5, c = wave >> 2, w4 = wave & 3;
    const int q0 = qb * 128, nt = 2 * qb + 2, jmax = 2 * qb + (w4 >> 1);
    const size_t tok0 = (size_t)b * SEQ;
    LAS float* wsf = (LAS float*)(lds + WSF_OFF) + wave * 64;
    bf16x8 qr[4];
    { const bf16* qp = Q + (tok0 + q0 + 32 * w4 + r32) * 512 + h * 128 + c * 64 + hi * 8;
#pragma unroll
      for (int d0 = 0; d0 < 4; ++d0) qr[d0] = *(const bf16x8*)(qp + 16 * d0); }
    const bf16* kg = K + (tok0 + lane) * 512 + h * 128 + wave * 8;
    const unsigned kl = wave * 1024 + lane * 16;
    const bf16* vg[2]; unsigned vl[2];
#pragma unroll
    for (int i = 0; i < 2; ++i) { const int rest = (lane >> 5) | (wave << 1) | (i << 4), eb = rest & 3, kb8 = rest >> 2, key = 8 * kb8 + ((lane >> 2) & 7), ech = 4 * eb + (lane & 3);
        vg[i] = V + (tok0 + key) * 512 + h * 128 + ech * 8; vl[i] = 16384 + (eb * 8 + kb8) * 512 + (key & 7) * 64 + (ech & 3) * 16; }
    const unsigned kfr = c * 8192 + hi * 1024 + r32 * 16;
    const unsigned vfr = 16384 + (4 * hi + ((lane & 15) >> 2)) * 64 + ((lane >> 4) & 1) * 32 + (lane & 3) * 8;
    u32x4 rk0, rk1, rv0, rv1;
#define DA_LOAD(j) do { const size_t go_ = (size_t)(j) * 64 * 512; rk0 = *(const u32x4*)(kg + go_); rk1 = *(const u32x4*)(kg + go_ + 64); rv0 = *(const u32x4*)(vg[0] + go_); rv1 = *(const u32x4*)(vg[1] + go_); } while (0)
#define DA_STORE(bo) do { *(LAS u32x4*)(lds + (bo) + kl) = rk0; *(LAS u32x4*)(lds + (bo) + 8192 + kl) = rk1; *(LAS u32x4*)(lds + (bo) + vl[0]) = rv0; *(LAS u32x4*)(lds + (bo) + vl[1]) = rv1; } while (0)
    f32x16 o[4];
#pragma unroll
    for (int e = 0; e < 4; ++e) o[e] = f32x16{};
    f32x16 negm = f32x16{}; float mhat = 0.f, lsum = 0.f;
    DA_LOAD(0); DA_STORE(0);
    __syncthreads();
    for (int j = 0; j < nt; ++j) {
        const unsigned bo = (j & 1) * 32768, bn = ((j + 1) & 1) * 32768;
        if (j + 1 < nt) DA_LOAD(j + 1);
        if (j <= jmax) tile_compute<4>(lds + bo + kfr, 2048, lds + bo + vfr, qr, o, negm, mhat, lsum, wsf, r32, hi);
        if (j + 1 < nt) DA_STORE(bn);
        __syncthreads();
    }
#undef DA_LOAD
#undef DA_STORE
    int r32e = r32, hie = hi; asm volatile("" : "+v"(r32e), "+v"(hie));
    lsum = half_swap_sum(lsum);
    if (hie == 0) wsf[32 + r32e] = lsum;
    asm volatile("s_waitcnt lgkmcnt(0)" ::: "memory");
#pragma unroll
    for (int r = 0; r < 16; ++r) { const float rl = 1.0f / wsf[32 + crow(r, hie)];
#pragma unroll
        for (int e = 0; e < 4; ++e) o[e][r] *= rl; }
    LAS float* xch = (LAS float*)(lds + XCH_OFF);
    if (c == 1) {
#pragma unroll
        for (int r = 0; r < 16; ++r)
#pragma unroll
            for (int e = 0; e < 4; ++e) xch[(32 * w4 + crow(r, hie)) * 128 + 32 * e + r32e] = o[e][r];
    }
    __syncthreads();
    if (c == 0) {
        float sub[4];
#pragma unroll
        for (int e = 0; e < 4; ++e) sub[e] = subln[32 * e + r32e] * 0.8f;
#pragma unroll
        for (int r = 0; r < 16; ++r) {
            float ss = 0.f;
#pragma unroll
            for (int e = 0; e < 4; ++e) { const float x = o[e][r] - lam * xch[(32 * w4 + crow(r, hie)) * 128 + 32 * e + r32e]; o[e][r] = x; ss += x * x; }
            ss += __shfl_xor(ss, 1); ss += __shfl_xor(ss, 2); ss += __shfl_xor(ss, 4); ss += __shfl_xor(ss, 8); ss += __shfl_xor(ss, 16);
            const float rstd = 1.0f / sqrtf(ss * (1.f / 128.f) + RMS_EPS);
            bf16* yp = Y + (tok0 + q0 + 32 * w4 + crow(r, hie)) * DM + h * 128 + r32e;
#pragma unroll
            for (int e = 0; e < 4; ++e) yp[32 * e] = (bf16)f2bf(o[e][r] * rstd * sub[e]);
        }
    }
}

__device__ __forceinline__ void mla_unit(LAS unsigned char* lds, int b, int h, int qb, const bf16* Q1, const bf16* KV1, const bf16* KR, bf16* Y, int wave, int lane_in) {
    int lane = lane_in; asm volatile("" : "+v"(lane));
    const int r32 = lane & 31, hi = lane >> 5;
    const int q0 = qb * 256, nt = 4 * qb + 4, jmax = 4 * qb + (wave >> 1);
    const size_t tok0 = (size_t)b * SEQ;
    LAS float* wsf = (LAS float*)(lds + WSF_OFF) + wave * 64;
    bf16x8 qr[12];
    { const bf16* qp = Q1 + (tok0 + q0 + 32 * wave + r32) * 1152 + h * 192 + hi * 8;
#pragma unroll
      for (int d0 = 0; d0 < 12; ++d0) qr[d0] = *(const bf16x8*)(qp + 16 * d0); }
    const bf16* kg = KV1 + (tok0 + lane) * 1536 + h * 256 + wave * 8;
    const bf16* kgr = KR + (tok0 + lane) * 64 + wave * 8;
    const unsigned kl = wave * 1024 + lane * 16;
    const bf16* vg[2]; unsigned vl[2];
#pragma unroll
    for (int i = 0; i < 2; ++i) { const int rest = (lane >> 5) | (wave << 1) | (i << 4), eb = rest & 3, kb8 = rest >> 2, key = 8 * kb8 + ((lane >> 2) & 7), ech = 4 * eb + (lane & 3);
        vg[i] = KV1 + (tok0 + key) * 1536 + h * 256 + 128 + ech * 8; vl[i] = 24576 + (eb * 8 + kb8) * 512 + (key & 7) * 64 + (ech & 3) * 16; }
    const unsigned kfr = hi * 1024 + r32 * 16;
    const unsigned vfr = 24576 + (4 * hi + ((lane & 15) >> 2)) * 64 + ((lane >> 4) & 1) * 32 + (lane & 3) * 8;
    u32x4 rk0, rk1, rk2, rv0, rv1;
#define ML_LOAD(j) do { const size_t t_ = (size_t)(j) * 64; rk0 = *(const u32x4*)(kg + t_ * 1536); rk1 = *(const u32x4*)(kg + t_ * 1536 + 64); rk2 = *(const u32x4*)(kgr + t_ * 64); \
        rv0 = *(const u32x4*)(vg[0] + t_ * 1536); rv1 = *(const u32x4*)(vg[1] + t_ * 1536); } while (0)
#define ML_STORE(bo) do { *(LAS u32x4*)(lds + (bo) + kl) = rk0; *(LAS u32x4*)(lds + (bo) + 8192 + kl) = rk1; *(LAS u32x4*)(lds + (bo) + 16384 + kl) = rk2; \
        *(LAS u32x4*)(lds + (bo) + vl[0]) = rv0; *(LAS u32x4*)(lds + (bo) + vl[1]) = rv1; } while (0)
    f32x16 o[4];
#pragma unroll
    for (int e = 0; e < 4; ++e) o[e] = f32x16{};
    f32x16 negm = f32x16{}; float mhat = 0.f, lsum = 0.f;
    ML_LOAD(0); ML_STORE(0);
    __syncthreads();
    for (int j = 0; j < nt; ++j) {
        const unsigned bo = (j & 1) * 40960, bn = ((j + 1) & 1) * 40960;
        if (j + 1 < nt) ML_LOAD(j + 1);
        if (j <= jmax) tile_compute<12>(lds + bo + kfr, 2048, lds + bo + vfr, qr, o, negm, mhat, lsum, wsf, r32, hi);
        if (j + 1 < nt) ML_STORE(bn);
        __syncthreads();
    }
#undef ML_LOAD
#undef ML_STORE
    int r32e = r32, hie = hi; asm volatile("" : "+v"(r32e), "+v"(hie));
    lsum = half_swap_sum(lsum);
    if (hie == 0) wsf[32 + r32e] = lsum;
    asm volatile("s_waitcnt lgkmcnt(0)" ::: "memory");
#pragma unroll
    for (int r = 0; r < 16; ++r) { const float rl = 1.0f / wsf[32 + crow(r, hie)];
        bf16* yp = Y + (tok0 + q0 + 32 * wave + crow(r, hie)) * DM + 256 + h * 128 + r32e;
#pragma unroll
        for (int e = 0; e < 4; ++e) yp[32 * e] = (bf16)f2bf(o[e][r] * rl); }
    asm volatile("s_waitcnt lgkmcnt(0)" ::: "memory");
}
}
constexpr int NPHASE = 17;
__global__ void __launch_bounds__(NTHREADS, 2) mega_fwd(Args a_unused) {
    extern __shared__ __attribute__((aligned(16))) unsigned char lds_raw[];
    LAS unsigned char* lds = (LAS unsigned char*)lds_raw;
    const int wave = __builtin_amdgcn_readfirstlane(threadIdx.x >> 6);
    const int G = gridDim.x, bid = blockIdx.x;
    const int gw = bid * NWAVES + wave, NGW = G * NWAVES;
    const ArgsP ap0 = (ArgsP)__builtin_amdgcn_kernarg_segment_ptr();
    for (int u = wave * 64 + fresh_lane(); u < (LDS_BYTES - LDSCTL_OFF) / 4; u += NTHREADS) ((LAS unsigned*)(lds + LDSCTL_OFF))[u] = 0u;
    __syncthreads();
    XcdBarrier bar; bar.bar = (unsigned*)(ap0->ws) + CW_BAR; bar.x = 0; bar.st = nullptr;
#if !MK_PER_PHASE
    bar = xcd_barrier_post((unsigned*)(ap0->ws) + CW_BAR, (volatile LAS unsigned*)(lds + MISC_OFF) + 8, wave == 0 && fresh_lane() == 0);
#endif
    const int lo = ap0->ph_lo, hi = ap0->ph_hi;
#define IN(k) (lo <= (k) && (k) < hi)
#define PTRS const int lane = fresh_lane(); (void)lane; ArgsP a = launder(ap0); unsigned char* ws = a->ws; (void)ws; \
        float* ropeA = (float*)(ws + WS_ROPEA); float* ropeD = (float*)(ws + WS_ROPED); bf16* XN = (bf16*)(ws + WS_XN); bf16* Y = (bf16*)(ws + WS_XN); \
        float* MIX = (float*)(ws + WS_MIX); float* P1OUT = (float*)(ws + WS_MIX); bf16* Hb = (bf16*)(ws + WS_H); \
        bf16* Qb = (bf16*)(ws + WS_Q); bf16* Kb = (bf16*)(ws + WS_K); bf16* Vb = (bf16*)(ws + WS_V); bf16* Ub = (bf16*)(ws + WS_U); \
        bf16* Q1 = (bf16*)(ws + WS_Q1); bf16* KV1 = (bf16*)(ws + WS_KV1); bf16* Zb = (bf16*)(ws + WS_Z); bf16* CQN = (bf16*)(ws + WS_CQN); bf16* CKVN = (bf16*)(ws + WS_CKVN); bf16* KR = (bf16*)(ws + WS_KR); \
        float* out = a->out; (void)ropeA; (void)ropeD; (void)XN; (void)Y; (void)MIX; (void)P1OUT; (void)Hb; (void)Qb; (void)Kb; (void)Vb; (void)Ub; (void)Q1; (void)KV1; (void)Zb; (void)CQN; (void)CKVN; (void)KR; (void)out;
#define SEAM(k) do { if (IN(k) && IN((k) + 1)) xcd_barrier(bar, wave == 0 && fresh_lane() == 0); } while (0)
#define GEMM_RUN(EpiT, E, Aptr, Bptr, M_, N_, K_, coff) do { int kk_ = (K_); asm volatile("" : "+s"(kk_));   \
        pg8::Gemm g_{(const pg8::bf16_t*)(Aptr), (const pg8::bf16_t*)(Bptr), M_, N_, kk_}; pg8::StaticOrder S_; \
        S_.init(M_, N_, G, (bid + (coff)) % G); pg8::gemm_phase<EpiT, pg8::StaticOrder, true, true>(lds, g_, S_, E, wave); } while (0)

    if (IN(0)) { PTRS
        LAS float* scr = (LAS float*)(lds + wave * 16384);
        int base = 0;
        for (int m = 0; m < 11; ++m) {
            const WMat w = wmat(m); const int nitems = (w.K / 64) * (w.N / 32);
            int j = (gw - base % NGW + NGW) % NGW;
            for (; j < nitems; j += NGW) p0_transpose_item(a, m, w, j, scr, lane);
            base += nitems;
        }
        for (int i = gw * 64 + lane; i < SEQ * 8; i += NGW * 64) { const int s = i >> 3, k = i & 7; const float inv = powf(500000.0f, -(float)(2 * k) / 16.0f); const float ang = (float)s * inv;
            ropeA[2 * i] = cosf(ang); ropeA[2 * i + 1] = sinf(ang); }
        for (int i = gw * 64 + lane; i < SEQ * 32; i += NGW * 64) { const int s = i >> 5, k = i & 31; const float inv = powf(10000.0f, -(float)(2 * k) / 64.0f); const float ang = (float)s * inv;
            ropeD[2 * i] = cosf(ang); ropeD[2 * i + 1] = sinf(ang); }
        for (int r = gw; r < TOK; r += NGW) row_norm(a->in[0] + (size_t)r * DM, a->in[1], XN + (size_t)r * DM, lane);
    }
    SEAM(0);
    if (IN(1)) { PTRS
        pg8::EpiProj0 E{Qb, Kb, Vb, Ub, ropeA, 0.125f * LOG2E};
        GEMM_RUN(pg8::EpiProj0, E, XN, ws + WS_W0IN, TOK, 2560, 1024, 0);
    }
    SEAM(1);
    if (IN(2)) { PTRS
        const float d1 = wave_sum(a->in[4][lane] * a->in[5][lane]), d2 = wave_sum(a->in[6][lane] * a->in[7][lane]);
        const float lam = expf(d1) - expf(d2) + 0.2f;
        const int vcu = (G % 8 == 0) ? (bid % 8) * (G / 8) + bid / 8 : bid;
        for (int p = vcu; p < 256; p += G) {
            const int bh = p >> 3, sidx = p & 7;
            att::diff_unit(lds, bh >> 2, bh & 3, 15 - sidx, Qb, Kb, Vb, Y, lam, a->in[8], wave, lane);
            att::diff_unit(lds, bh >> 2, bh & 3, sidx, Qb, Kb, Vb, Y, lam, a->in[8], wave, lane);
        }
        const float* dw_w = a->in[9]; const float* dw_b = a->in[10]; const float* ln_g = a->in[11]; const float* ln_b = a->in[12];
        for (int t = gw; t < TOK; t += NGW) {
            const int s = t % SEQ;
            f32x4 c0 = ((const f32x4*)dw_b)[2 * lane], c1 = ((const f32x4*)dw_b)[2 * lane + 1];
            for (int j = 0; j < 31; ++j) {
                if (s - 30 + j < 0) continue;
                const u32x4 uw = *(const u32x4*)(Ub + (size_t)(t - 30 + j) * 512 + 8 * lane);
                const f32x4 w0 = ((const f32x4*)(dw_w + j * 512))[2 * lane], w1 = ((const f32x4*)(dw_w + j * 512))[2 * lane + 1];
                c0[0] += bf_lo_(uw.x) * w0[0]; c0[1] += bf_hi_(uw.x) * w0[1]; c0[2] += bf_lo_(uw.y) * w0[2]; c0[3] += bf_hi_(uw.y) * w0[3];
                c1[0] += bf_lo_(uw.z) * w1[0]; c1[1] += bf_hi_(uw.z) * w1[1]; c1[2] += bf_lo_(uw.w) * w1[2]; c1[3] += bf_hi_(uw.w) * w1[3];
            }
            const float mu = wave_sum((c0[0] + c0[1]) + (c0[2] + c0[3]) + (c1[0] + c1[1]) + (c1[2] + c1[3])) * (1.f / 512.f);
            c0 = c0 - mu; c1 = c1 - mu;
            const float rstd = 1.0f / sqrtf(wave_sum(dot4(c0, c0) + dot4(c1, c1)) * (1.f / 512.f) + LN_EPS);
            const f32x4 g0 = ((const f32x4*)ln_g)[2 * lane], g1 = ((const f32x4*)ln_g)[2 * lane + 1], e0 = ((const f32x4*)ln_b)[2 * lane], e1 = ((const f32x4*)ln_b)[2 * lane + 1];
            f32x4 y0 = c0 * rstd * g0 + e0, y1 = c1 * rstd * g1 + e1;
#pragma unroll
            for (int k = 0; k < 4; ++k) { y0[k] = y0[k] * pg8::sigm(y0[k]); y1[k] = y1[k] * pg8::sigm(y1[k]); }
            u32x4 o; o.x = pk2(y0[0], y0[1]); o.y = pk2(y0[2], y0[3]); o.z = pk2(y1[0], y1[1]); o.w = pk2(y1[2], y1[3]);
            *(u32x4*)(Y + (size_t)t * DM + 512 + 8 * lane) = o;
        }
    }
    SEAM(2);
    if (IN(3)) { PTRS pg8::EpiF32 E{MIX, DM}; GEMM_RUN(pg8::EpiF32, E, Y, ws + WS_W0OUT, TOK, DM, DM, 0); }
    SEAM(3);
    if (IN(4)) { PTRS for (int r = gw; r < TOK; r += NGW) row_norm_res(MIX + (size_t)r * DM, a->in[0] + (size_t)r * DM, a->in[2], out + (size_t)r * DM, a->in[14], XN + (size_t)r * DM, lane); }
    SEAM(4);
    if (IN(5)) { PTRS pg8::EpiGateUp E{Hb, DFF}; GEMM_RUN(pg8::EpiGateUp, E, XN, ws + WS_W0GU, TOK, 2 * DFF, DM, 0); }
    SEAM(5);
    if (IN(6)) { PTRS pg8::EpiF32 E{MIX, DM}; GEMM_RUN(pg8::EpiF32, E, Hb, ws + WS_W0DN, TOK, DM, DFF, 0); }
    SEAM(6);
    if (IN(7)) { PTRS for (int r = gw; r < TOK; r += NGW) row_norm_res(MIX + (size_t)r * DM, out + (size_t)r * DM, a->in[15], out + (size_t)r * DM, a->in[19], XN + (size_t)r * DM, lane); }
    SEAM(7);
    if (IN(8)) { PTRS pg8::EpiF32 E{P1OUT, 768}; GEMM_RUN(pg8::EpiF32, E, XN, ws + WS_W1IN, TOK, 768, DM, 0); }
    SEAM(8);
    if (IN(9)) { PTRS
        for (int r = gw; r < TOK; r += NGW) row_latent(P1OUT + (size_t)r * 768, r % SEQ, a->in[32], a->in[34], ropeD, CQN + (size_t)r * 256, CKVN + (size_t)r * 256, KR + (size_t)r * 64, lane);
        if (bid < BATCH * 16 && wave == 0) {
            const int b = bid >> 4, g = bid & 15, p = lane;
            const float lr = a->in[22][g * 64 + p], li = a->in[23][g * 64 + p], dt = expf(a->in[24][g]);
            const float mag = expf(lr * dt), abr = mag * cosf(li * dt), abi = mag * sinf(li * dt);
            const float den = lr * lr + li * li, nre = abr - 1.f;
            const float fre = (nre * lr + abi * li) / den, fim = (abi * lr - nre * li) / den;
            float bbr[16], bbi[16], cr[16], ci[16];
#pragma unroll
            for (int h = 0; h < 16; ++h) {
                const float br = a->in[25][(g * 64 + p) * 16 + h], bi = a->in[26][(g * 64 + p) * 16 + h];
                bbr[h] = fre * br - fim * bi; bbi[h] = fre * bi + fim * br;
                cr[h] = a->in[27][(g * 16 + h) * 64 + p]; ci[h] = a->in[28][(g * 16 + h) * 64 + p];
            }
            const float dsk = a->in[29][g * 16 + (p & 15)];
            float xr = 0.f, xi = 0.f;
            for (int s = 0; s < SEQ; ++s) {
                const float* up = P1OUT + (size_t)(b * SEQ + s) * 768 + g * 16;
                float ur = 0.f, ui = 0.f, myu = 0.f;
#pragma unroll
                for (int h = 0; h < 16; ++h) { const float u = up[h]; ur += u * bbr[h]; ui += u * bbi[h]; if ((p & 15) == h) myu = u; }
                const float nxr = abr * xr - abi * xi + ur, nxi = abr * xi + abi * xr + ui;
                xr = nxr; xi = nxi;
                float yv = 0.f;
#pragma unroll
                for (int h = 0; h < 16; ++h) { const float v = wave_sum(xr * cr[h] - xi * ci[h]); if (p == h) yv = v; }
                if (p < 16) {
                    const float y = yv + dsk * myu;
                    const float z = 0.5f * y * (1.f + tanhf(0.7978845608028654f * (y + 0.044715f * y * y * y)));
                    Zb[(size_t)(b * SEQ + s) * 256 + g * 16 + p] = (bf16)f2bf(z);
                }
            }
        }
    }
    SEAM(9);
    if (IN(10)) { PTRS
        { pg8::EpiQup E{Q1, ropeD, 0.07216878364870323f * LOG2E}; GEMM_RUN(pg8::EpiQup, E, CQN, ws + WS_W1UQ, TOK, 1280, 256, 0); }
        { pg8::EpiBf16Plain E{KV1, 1536}; GEMM_RUN(pg8::EpiBf16Plain, E, CKVN, ws + WS_W1UKV, TOK, 1536, 256, 192); }
        { pg8::EpiSsmGate E{Zb, a->in[31], Y, DM}; GEMM_RUN(pg8::EpiSsmGate, E, Zb, ws + WS_W1GLU, TOK, 256, 256, 64); }
    }
    SEAM(10);
    if (IN(11)) { PTRS
        const int vcu = (G % 8 == 0) ? (bid % 8) * (G / 8) + bid / 8 : bid;
        for (int p = vcu; p < 192; p += G) {
            const int bh = p >> 2, sidx = p & 3;
            att::mla_unit(lds, bh / 6, bh % 6, 7 - sidx, Q1, KV1, KR, Y, wave, lane);
            att::mla_unit(lds, bh / 6, bh % 6, sidx, Q1, KV1, KR, Y, wave, lane);
        }
    }
    SEAM(11);
    if (IN(12)) { PTRS pg8::EpiF32 E{MIX, DM}; GEMM_RUN(pg8::EpiF32, E, Y, ws + WS_W1OUT, TOK, DM, DM, 0); }
    SEAM(12);
    if (IN(13)) { PTRS for (int r = gw; r < TOK; r += NGW) row_norm_res(MIX + (size_t)r * DM, out + (size_t)r * DM, a->in[20], out + (size_t)r * DM, a->in[37], XN + (size_t)r * DM, lane); }
    SEAM(13);
    if (IN(14)) { PTRS pg8::EpiGateUp E{Hb, DFF}; GEMM_RUN(pg8::EpiGateUp, E, XN, ws + WS_W1GU, TOK, 2 * DFF, DM, 0); }
    SEAM(14);
    if (IN(15)) { PTRS pg8::EpiF32 E{MIX, DM}; GEMM_RUN(pg8::EpiF32, E, Hb, ws + WS_W1DN, TOK, DM, DFF, 0); }
    SEAM(15);
    if (IN(16)) { PTRS for (int r = gw; r < TOK; r += NGW) row_norm_res(MIX + (size_t)r * DM, out + (size_t)r * DM, a->in[38], out + (size_t)r * DM, nullptr, nullptr, lane); }
#undef IN
#undef PTRS
#undef SEAM
#undef GEMM_RUN
}

extern "C" void kernel_launch(void* const* d_in, const int* in_sizes, int n_in, void* d_out, int out_size, void* d_ws, size_t ws_size, hipStream_t stream) {
    static int grid = 0;
    if (grid == 0) {
        if (n_in != 42 || out_size != TOK * DM || ws_size < WS_END) { fprintf(stderr, "kernel_launch: unexpected problem shape (n_in %d out %d ws %zu)\n", n_in, out_size, ws_size); grid = -1; return; }
        int dev = 0, cus = 0, per_cu = 0;
        (void)hipGetDevice(&dev);
        (void)hipDeviceGetAttribute(&cus, hipDeviceAttributeMultiprocessorCount, dev);
        if (hipFuncSetAttribute((const void*)mega_fwd, hipFuncAttributeMaxDynamicSharedMemorySize, LDS_BYTES) != hipSuccess) { fprintf(stderr, "kernel_launch: hipFuncSetAttribute failed\n"); grid = -1; return; }
        if (hipOccupancyMaxActiveBlocksPerMultiprocessor(&per_cu, (const void*)mega_fwd, NTHREADS, LDS_BYTES) != hipSuccess || per_cu < 1) { fprintf(stderr, "kernel_launch: occupancy query says %d blocks per CU\n", per_cu); grid = -1; return; }
        (void)hipGetLastError();
        grid = cus;
        if (grid > 256) grid = 256;
        fprintf(stderr, "kernel_launch: %d CUs, %d blocks/CU by the occupancy query, grid %d\n", cus, per_cu, grid);
    }
    if (grid < 0) return;
    if (hipMemsetAsync(d_ws, 0, CTL_ZERO_BYTES, stream) != hipSuccess) { fprintf(stderr, "kernel_launch: hipMemsetAsync failed\n"); return; }
    Args a{};
    for (int i = 0; i < 42; ++i) a.in[i] = (const float*)d_in[i];
    a.out = (float*)d_out; a.ws = (unsigned char*)d_ws;
#if MK_PER_PHASE
    for (int p = 0; p < NPHASE; ++p) {
        a.ph_lo = p; a.ph_hi = p + 1;
        void* args[] = {&a};
        hipError_t e = hipLaunchCooperativeKernel((void*)mega_fwd, dim3(grid), dim3(NTHREADS), args, LDS_BYTES, stream);
        if (e != hipSuccess) { fprintf(stderr, "kernel_launch: phase %d launch failed: %s\n", p, hipGetErrorString(e)); break; }
    }
#else
    a.ph_lo = 0; a.ph_hi = NPHASE;
    void* args[] = {&a};
    hipError_t e = hipLaunchCooperativeKernel((void*)mega_fwd, dim3(grid), dim3(NTHREADS), args, LDS_BYTES, stream);
    if (e != hipSuccess) fprintf(stderr, "kernel_launch: cooperative launch failed: %s (grid %d)\n", hipGetErrorString(e), grid);
#endif
}
```

```cpp
#include <hip/hip_runtime.h>
#include <cstdio>
#include <cstdint>
#include <math.h>
namespace pg8 {
#define PG8_LAS __attribute__((address_space(3)))
typedef unsigned short bf16_t;
typedef short bf16x8 __attribute__((ext_vector_type(8)));
typedef float f32x4 __attribute__((ext_vector_type(4)));
typedef unsigned u32x4 __attribute__((ext_vector_type(4)));
constexpr int BM = 256, BK = 64, HALF = 128, HTB = HALF * BK * 2  , STAGE_BYTES = 8 * HTB, NXCD = 8, WGM = 8;

__host__ __device__ __forceinline__ int lds_byte(int r, int c) { const int st = (r >> 4) * 2 + (c >> 5), rr = r & 15, cc = c & 31, ob = rr * 64 + cc * 2; return st * 1024 + (ob ^ (((ob >> 9) & 1) << 5)); }
__host__ __device__ __forceinline__ void stage_rc(int b, int& R, int& C) { const int st = b / 1024, sb = b % 1024, swz = sb ^ (((sb >> 9) & 1) << 5); R = (st >> 1) * 16 + swz / 64; C = (st & 1) * 32 + (swz % 64) / 2; }
__host__ __device__ __forceinline__ int perm32(int rho) { const int n = rho >> 4, i = rho & 15; return 8 * (i >> 2) + 4 * n + (i & 3); }

struct Unit { int pm, pn; };
struct Gemm { const bf16_t* A; const bf16_t* Bt; int M, N, K; };

struct StaticOrder {
    int nM, nN, nwg, G, c;
    __host__ __device__ void init(int M, int N, int G_, int c_) { nM = M / BM; nN = N / BM; nwg = nM * nN; G = G_; c = c_; }
    __host__ __device__ bool next(int i, Unit& u) const {
        const long L = (long)i * G + c; if (L >= nwg) return false;
        int wgid = (int)L; { const int q = nwg / NXCD, r = nwg % NXCD, xcd = wgid % NXCD, off = wgid / NXCD; wgid = (xcd < r ? xcd * (q + 1) : r * (q + 1) + (xcd - r) * q) + off; }
        const int nig = WGM * nN, gid = wgid / nig, fm = gid * WGM, gsz = (nM - fm) < WGM ? (nM - fm) : WGM;
        u.pm = fm + ((wgid % nig) % gsz); u.pn = (wgid % nig) / gsz; return true;
    }
    __device__ __forceinline__ void a_ready(const Unit&) const {}
    __device__ __forceinline__ void done(const Unit&) const {}
};

#define MK_PER_PHASE 0

__device__ __forceinline__ unsigned cvt_pk_bf16(float lo, float hi) { unsigned r; asm volatile("v_cvt_pk_bf16_f32 %0, %1, %2" : "=v"(r) : "v"(lo), "v"(hi)); return r; }
__device__ __forceinline__ void st8(bf16_t* p, const f32x4 v0, const f32x4 v1) {
    u32x4 w; w.x = cvt_pk_bf16(v0[0], v0[1]); w.y = cvt_pk_bf16(v0[2], v0[3]); w.z = cvt_pk_bf16(v1[0], v1[1]); w.w = cvt_pk_bf16(v1[2], v1[3]); *(u32x4*)p = w;
}
__device__ __forceinline__ float sigm(float x) { return __builtin_amdgcn_rcpf(1.f + __builtin_amdgcn_exp2f(-1.4426950408889634f * x)); }
__device__ __forceinline__ float bf_lo(unsigned w) { return __uint_as_float(w << 16); }
__device__ __forceinline__ float bf_hi(unsigned w) { return __uint_as_float(w & 0xffff0000u); }

struct EpiF32 {
    static constexpr bool PERM = false, AFTER_DRAIN = false;
    float* C; int ldc;
    __device__ __forceinline__ void operator()(const f32x4 (&acc)[2][2][4][2], const Unit& u, int wr, int wc, int fr, int fq) const {
        const int row0 = u.pm * BM + wr * 64 + fr, col0 = u.pn * BM + wc * 32 + 4 * fq;
#pragma unroll
        for (int ai = 0; ai < 2; ++ai)
#pragma unroll
            for (int m = 0; m < 4; ++m) { float* rowp = C + (size_t)(row0 + ai * HALF + m * 16) * ldc + col0;
#pragma unroll
                for (int bj = 0; bj < 2; ++bj)
#pragma unroll
                    for (int n = 0; n < 2; ++n) *(f32x4*)(rowp + bj * HALF + n * 16) = acc[ai][bj][m][n]; }
    }
};
struct EpiBf16Plain {
    static constexpr bool PERM = true, AFTER_DRAIN = false;
    bf16_t* O; int ldc;
    __device__ __forceinline__ void operator()(const f32x4 (&acc)[2][2][4][2], const Unit& u, int wr, int wc, int fr, int fq) const {
        const int row0 = u.pm * BM + wr * 64 + fr, col0 = u.pn * BM + wc * 32 + 8 * fq;
#pragma unroll
        for (int ai = 0; ai < 2; ++ai)
#pragma unroll
            for (int m = 0; m < 4; ++m) { bf16_t* rowp = O + (size_t)(row0 + ai * HALF + m * 16) * ldc + col0;
#pragma unroll
                for (int bj = 0; bj < 2; ++bj) st8(rowp + bj * HALF, acc[ai][bj][m][0], acc[ai][bj][m][1]); }
    }
};
struct EpiProj0 {
    static constexpr bool PERM = true, AFTER_DRAIN = false;
    bf16_t *Q, *Kb, *V, *U; const float* ropeA; float qscale;
    __device__ __forceinline__ void operator()(const f32x4 (&acc)[2][2][4][2], const Unit& u, int wr, int wc, int fr, int fq) const {
        const int row0 = u.pm * BM + wr * 64 + fr, pn = u.pn;
        if (pn < 4) {
            bf16_t* base = (pn < 2 ? Q : Kb) + (pn & 1) * 256 + wc * 32 + 8 * fq;
            const float sc = pn < 2 ? qscale : 1.f;
            const bool ropew = (wc & 1) == 0;
            const bool ropel = fq < 2;
#pragma unroll
            for (int ai = 0; ai < 2; ++ai)
#pragma unroll
                for (int m = 0; m < 4; ++m) {
                    const int row = row0 + ai * HALF + m * 16;
                    f32x4 cs0 = {1.f, 0.f, 1.f, 0.f}, cs1 = {1.f, 0.f, 1.f, 0.f};
                    if (ropew) { const float* rp = ropeA + ((size_t)(row & 2047) * 8 + 4 * (fq & 1)) * 2; cs0 = *(const f32x4*)rp; cs1 = *(const f32x4*)(rp + 4); }
#pragma unroll
                    for (int bj = 0; bj < 2; ++bj) {
                        f32x4 v0 = acc[ai][bj][m][0], v1 = acc[ai][bj][m][1];
                        if (ropew) {
                            f32x4 r0, r1;
                            r0[0] = v0[0] * cs0[0] - v1[0] * cs0[1]; r1[0] = v1[0] * cs0[0] + v0[0] * cs0[1];
                            r0[1] = v0[1] * cs0[2] - v1[1] * cs0[3]; r1[1] = v1[1] * cs0[2] + v0[1] * cs0[3];
                            r0[2] = v0[2] * cs1[0] - v1[2] * cs1[1]; r1[2] = v1[2] * cs1[0] + v0[2] * cs1[1];
                            r0[3] = v0[3] * cs1[2] - v1[3] * cs1[3]; r1[3] = v1[3] * cs1[2] + v0[3] * cs1[3];
                            if (ropel) { v0 = r0; v1 = r1; }
                        }
                        st8(base + (size_t)row * 512 + bj * HALF, v0 * sc, v1 * sc);
                    }
                    asm volatile("" ::: "memory");
                }
        } else if (pn < 6) {
            bf16_t* base = V + (pn - 4) * 256 + wc * 32 + 8 * fq;
#pragma unroll
            for (int ai = 0; ai < 2; ++ai)
#pragma unroll
                for (int m = 0; m < 4; ++m) { const int row = row0 + ai * HALF + m * 16;
#pragma unroll
                    for (int bj = 0; bj < 2; ++bj) st8(base + (size_t)row * 512 + bj * HALF, acc[ai][bj][m][0], acc[ai][bj][m][1]); }
        } else {
            bf16_t* base = U + (pn - 6) * 128 + wc * 32 + 8 * fq;
#pragma unroll
            for (int ai = 0; ai < 2; ++ai)
#pragma unroll
                for (int m = 0; m < 4; ++m) { const int row = row0 + ai * HALF + m * 16;
                    f32x4 o[2];
#pragma unroll
                    for (int n = 0; n < 2; ++n)
#pragma unroll
                        for (int j = 0; j < 4; ++j) o[n][j] = acc[ai][0][m][n][j] * sigm(acc[ai][1][m][n][j]);
                    st8(base + (size_t)row * 512, o[0], o[1]); }
        }
    }
};
struct EpiGateUp {
    static constexpr bool PERM = true, AFTER_DRAIN = false;
    bf16_t* H; int ldh;
    __device__ __forceinline__ void operator()(const f32x4 (&acc)[2][2][4][2], const Unit& u, int wr, int wc, int fr, int fq) const {
        const int row0 = u.pm * BM + wr * 64 + fr;
        bf16_t* base = H + u.pn * 128 + wc * 32 + 8 * fq;
#pragma unroll
        for (int ai = 0; ai < 2; ++ai)
#pragma unroll
            for (int m = 0; m < 4; ++m) { const int row = row0 + ai * HALF + m * 16;
                f32x4 o[2];
#pragma unroll
                for (int n = 0; n < 2; ++n)
#pragma unroll
                    for (int j = 0; j < 4; ++j) { const float g = acc[ai][0][m][n][j]; o[n][j] = g * sigm(g) * acc[ai][1][m][n][j]; }
                st8(base + (size_t)row * ldh, o[0], o[1]); }
    }
};
struct EpiQup {
    static constexpr bool PERM = true, AFTER_DRAIN = false;
    bf16_t* Q1; const float* ropeD; float qscale; const float* SSQ;
    __device__ __forceinline__ void operator()(const f32x4 (&acc)[2][2][4][2], const Unit& u, int wr, int wc, int fr, int fq) const {
        const int row0 = u.pm * BM + wr * 64 + fr;
#pragma unroll
        for (int bj = 0; bj < 2; ++bj) {
            const int cw = u.pn * BM + bj * HALF + wc * 32;
            if (cw >= 1152) continue;
            const bool rope = ((cw >> 6) % 3) == 2;
            const int i0 = 16 * (wc & 1) + 4 * fq;
#pragma unroll
            for (int ai = 0; ai < 2; ++ai)
#pragma unroll
                for (int m = 0; m < 4; ++m) { const int row = row0 + ai * HALF + m * 16;
                    f32x4 v0 = acc[ai][bj][m][0], v1 = acc[ai][bj][m][1];
                    const f32x4 pq = *(const f32x4*)(SSQ + (size_t)row * 4);
                    const float rs = qscale * __builtin_amdgcn_rsqf(((pq[0] + pq[1]) + (pq[2] + pq[3])) * (1.f / 256.f) + 1e-6f);
                    if (rope) {
                        const float* rp = ropeD + ((size_t)(row & 2047) * 32 + i0) * 2; const f32x4 cs0 = *(const f32x4*)rp, cs1 = *(const f32x4*)(rp + 4);
                        f32x4 r0, r1;
                        r0[0] = v0[0] * cs0[0] - v1[0] * cs0[1]; r1[0] = v1[0] * cs0[0] + v0[0] * cs0[1];
                        r0[1] = v0[1] * cs0[2] - v1[1] * cs0[3]; r1[1] = v1[1] * cs0[2] + v0[1] * cs0[3];
                        r0[2] = v0[2] * cs1[0] - v1[2] * cs1[1]; r1[2] = v1[2] * cs1[0] + v0[2] * cs1[1];
                        r0[3] = v0[3] * cs1[2] - v1[3] * cs1[3]; r1[3] = v1[3] * cs1[2] + v0[3] * cs1[3];
                        v0 = r0; v1 = r1;
                    }
                    st8(Q1 + (size_t)row * 1152 + cw + 8 * fq, v0 * rs, v1 * rs); asm volatile("" ::: "memory"); }
        }
    }
};
struct EpiSsmGate {
    static constexpr bool PERM = true, AFTER_DRAIN = false;
    const bf16_t* Z; const float* bias; bf16_t* Y; int ldy;
    __device__ __forceinline__ void operator()(const f32x4 (&acc)[2][2][4][2], const Unit& u, int wr, int wc, int fr, int fq) const {
        const int row0 = u.pm * BM + wr * 64 + fr;
#pragma unroll
        for (int bj = 0; bj < 2; ++bj) {
            const int c0 = bj * HALF + wc * 32 + 8 * fq;
            const f32x4 b0 = *(const f32x4*)(bias + c0), b1 = *(const f32x4*)(bias + c0 + 4);
#pragma unroll
            for (int ai = 0; ai < 2; ++ai)
#pragma unroll
                for (int m = 0; m < 4; ++m) { const int row = row0 + ai * HALF + m * 16;
                    const u32x4 zw = *(const u32x4*)(Z + (size_t)row * 256 + c0);
                    f32x4 o0, o1;
                    o0[0] = bf_lo(zw.x) * sigm(acc[ai][bj][m][0][0] + b0[0]); o0[1] = bf_hi(zw.x) * sigm(acc[ai][bj][m][0][1] + b0[1]);
                    o0[2] = bf_lo(zw.y) * sigm(acc[ai][bj][m][0][2] + b0[2]); o0[3] = bf_hi(zw.y) * sigm(acc[ai][bj][m][0][3] + b0[3]);
                    o1[0] = bf_lo(zw.z) * sigm(acc[ai][bj][m][1][0] + b1[0]); o1[1] = bf_hi(zw.z) * sigm(acc[ai][bj][m][1][1] + b1[1]);
                    o1[2] = bf_lo(zw.w) * sigm(acc[ai][bj][m][1][2] + b1[2]); o1[3] = bf_hi(zw.w) * sigm(acc[ai][bj][m][1][3] + b1[3]);
                    st8(Y + (size_t)row * ldy + c0, o0, o1); asm volatile("" ::: "memory"); }
        }
    }
};

struct EpiKVup {
    static constexpr bool PERM = true, AFTER_DRAIN = false;
    bf16_t* O; const float* SSKV;
    __device__ __forceinline__ void operator()(const f32x4 (&acc)[2][2][4][2], const Unit& u, int wr, int wc, int fr, int fq) const {
        const int row0 = u.pm * BM + wr * 64 + fr, col0 = u.pn * BM + wc * 32 + 8 * fq;
#pragma unroll
        for (int ai = 0; ai < 2; ++ai)
#pragma unroll
            for (int m = 0; m < 4; ++m) { const int row = row0 + ai * HALF + m * 16;
                const f32x4 pq = *(const f32x4*)(SSKV + (size_t)row * 4);
                const float rs = __builtin_amdgcn_rsqf(((pq[0] + pq[1]) + (pq[2] + pq[3])) * (1.f / 128.f) + 1e-6f);
#pragma unroll
                for (int bj = 0; bj < 2; ++bj) st8(O + (size_t)row * 1536 + col0 + bj * HALF, acc[ai][bj][m][0] * rs, acc[ai][bj][m][1] * rs);
                asm volatile("" ::: "memory"); }
    }
};
struct EpiProj1 {
    static constexpr bool PERM = true, AFTER_DRAIN = false;
    bf16_t *UT, *CQ, *CKV, *KR; float *SSQ, *SSKV; const float* ropeD;
    __device__ __forceinline__ void operator()(const f32x4 (&acc)[2][2][4][2], const Unit& u, int wr, int wc, int fr, int fq) const {
        const int row0 = u.pm * BM + wr * 64 + fr, pn = u.pn;
        if (pn == 0) {
#pragma unroll
            for (int ai = 0; ai < 2; ++ai)
#pragma unroll
                for (int m = 0; m < 4; ++m) { const int row = row0 + ai * HALF + m * 16, R = row >> 5, i = row & 31;
#pragma unroll
                    for (int bj = 0; bj < 2; ++bj) { const int c0 = bj * HALF + wc * 32 + 8 * fq, g = c0 >> 4, h0 = c0 & 15;
                        st8(UT + ((size_t)(g * 512 + R) * 512 + i * 16 + h0), acc[ai][bj][m][0], acc[ai][bj][m][1]); } }
        } else if (pn == 1) {
#pragma unroll
            for (int ai = 0; ai < 2; ++ai)
#pragma unroll
                for (int m = 0; m < 4; ++m) { const int row = row0 + ai * HALF + m * 16; float ss = 0.f;
#pragma unroll
                    for (int bj = 0; bj < 2; ++bj) { const f32x4 v0 = acc[ai][bj][m][0], v1 = acc[ai][bj][m][1];
                        ss += ((v0[0] * v0[0] + v0[1] * v0[1]) + (v0[2] * v0[2] + v0[3] * v0[3])) + ((v1[0] * v1[0] + v1[1] * v1[1]) + (v1[2] * v1[2] + v1[3] * v1[3]));
                        st8(CQ + (size_t)row * 256 + bj * HALF + wc * 32 + 8 * fq, v0, v1); }
                    ss += __shfl_xor(ss, 16); ss += __shfl_xor(ss, 32);
                    if (fq == 0) SSQ[(size_t)row * 4 + wc] = ss; }
        } else {
            const int i0 = 16 * (wc & 1) + 4 * fq;
#pragma unroll
            for (int ai = 0; ai < 2; ++ai)
#pragma unroll
                for (int m = 0; m < 4; ++m) { const int row = row0 + ai * HALF + m * 16;
                    { const f32x4 v0 = acc[ai][0][m][0], v1 = acc[ai][0][m][1];
                      float ss = ((v0[0] * v0[0] + v0[1] * v0[1]) + (v0[2] * v0[2] + v0[3] * v0[3])) + ((v1[0] * v1[0] + v1[1] * v1[1]) + (v1[2] * v1[2] + v1[3] * v1[3]));
                      st8(CKV + (size_t)row * 256 + wc * 32 + 8 * fq, v0, v1);
                      *(u32x4*)(CKV + (size_t)row * 256 + 128 + wc * 32 + 8 * fq) = (u32x4){0u, 0u, 0u, 0u};
                      ss += __shfl_xor(ss, 16); ss += __shfl_xor(ss, 32);
                      if (fq == 0) SSKV[(size_t)row * 4 + wc] = ss; }
                    if (wc < 2) { const f32x4 v0 = acc[ai][1][m][0], v1 = acc[ai][1][m][1];
                        const float* rp = ropeD + ((size_t)(row & 2047) * 32 + i0) * 2; const f32x4 cs0 = *(const f32x4*)rp, cs1 = *(const f32x4*)(rp + 4);
                        f32x4 r0, r1;
                        r0[0] = v0[0] * cs0[0] - v1[0] * cs0[1]; r1[0] = v1[0] * cs0[0] + v0[0] * cs0[1];
                        r0[1] = v0[1] * cs0[2] - v1[1] * cs0[3]; r1[1] = v1[1] * cs0[2] + v0[1] * cs0[3];
                        r0[2] = v0[2] * cs1[0] - v1[2] * cs1[1]; r1[2] = v1[2] * cs1[0] + v0[2] * cs1[1];
                        r0[3] = v0[3] * cs1[2] - v1[3] * cs1[3]; r1[3] = v1[3] * cs1[2] + v0[3] * cs1[3];
                        st8(KR + (size_t)row * 64 + wc * 32 + 8 * fq, r0, r1); }
                    asm volatile("" ::: "memory"); }
        }
    }
};
struct EpiSsmG1 {
    static constexpr bool PERM = false, AFTER_DRAIN = false;
    float *E, *YI;
    __device__ __forceinline__ void operator()(const f32x4 (&acc)[2][2][4][2], const Unit& u, int wr, int wc, int fr, int fq) const {
        const int g = u.pm >> 1, pnl = u.pn - 3 * g, R0 = (u.pm & 1) * BM + wr * 64 + fr;
#pragma unroll
        for (int bj = 0; bj < 2; ++bj) {
            const int cl0 = pnl * BM + bj * HALF;
            if (cl0 >= 640) continue;
            const int cw = cl0 + wc * 32 + 4 * fq;
#pragma unroll
            for (int ai = 0; ai < 2; ++ai)
#pragma unroll
                for (int m = 0; m < 4; ++m) { const size_t Rg = (size_t)g * 512 + R0 + ai * HALF + m * 16;
#pragma unroll
                    for (int n = 0; n < 2; ++n) {
                        if (cl0 < 128) *(f32x4*)(E + Rg * 128 + cw + n * 16) = acc[ai][bj][m][n];
                        else *(f32x4*)(YI + Rg * 512 + (cw - 128) + n * 16) = acc[ai][bj][m][n]; } }
        }
    }
};
struct EpiSsmOut {
    static constexpr bool PERM = true, AFTER_DRAIN = false;
    const float* YI; const bf16_t* UT; const float* dsk; bf16_t* Z;
    __device__ __forceinline__ void operator()(const f32x4 (&acc)[2][2][4][2], const Unit& u, int wr, int wc, int fr, int fq) const {
        const int g = u.pm >> 1, pnl = u.pn & 1, R0 = (u.pm & 1) * BM + wr * 64 + fr;
#pragma unroll
        for (int bj = 0; bj < 2; ++bj) {
            const int n0 = pnl * BM + bj * HALF + wc * 32 + 8 * fq, jt = n0 >> 4, h0 = n0 & 15;
            const f32x4 d0 = *(const f32x4*)(dsk + g * 16 + h0), d1 = *(const f32x4*)(dsk + g * 16 + h0 + 4);
#pragma unroll
            for (int ai = 0; ai < 2; ++ai)
#pragma unroll
                for (int m = 0; m < 4; ++m) { const int R = R0 + ai * HALF + m * 16; const size_t idx = ((size_t)g * 512 + R) * 512 + n0;
                    const f32x4 y0 = *(const f32x4*)(YI + idx), y1 = *(const f32x4*)(YI + idx + 4); const u32x4 uw = *(const u32x4*)(UT + idx);
                    f32x4 a0 = acc[ai][bj][m][0] + y0, a1 = acc[ai][bj][m][1] + y1;
                    a0[0] += d0[0] * bf_lo(uw.x); a0[1] += d0[1] * bf_hi(uw.x); a0[2] += d0[2] * bf_lo(uw.y); a0[3] += d0[3] * bf_hi(uw.y);
                    a1[0] += d1[0] * bf_lo(uw.z); a1[1] += d1[1] * bf_hi(uw.z); a1[2] += d1[2] * bf_lo(uw.w); a1[3] += d1[3] * bf_hi(uw.w);
#pragma unroll
                    for (int k = 0; k < 4; ++k) {
                        { const float y = a0[k], t = 0.7978845608028654f * (y + 0.044715f * y * y * y); const float e = __builtin_amdgcn_exp2f(2.885390081777927f * t); a0[k] = 0.5f * y * (2.f - 2.f * __builtin_amdgcn_rcpf(1.f + e)); }
                        { const float y = a1[k], t = 0.7978845608028654f * (y + 0.044715f * y * y * y); const float e = __builtin_amdgcn_exp2f(2.885390081777927f * t); a1[k] = 0.5f * y * (2.f - 2.f * __builtin_amdgcn_rcpf(1.f + e)); }
                    }
                    st8(Z + ((size_t)R * 32 + jt) * 256 + g * 16 + h0, a0, a1);
                    asm volatile("" ::: "memory"); }
        }
    }
};
struct BatchOrder {
    int tm, tn, nunits, G, c;
    __device__ __forceinline__ bool next(int i, Unit& u) const {
        const int L = i * G + c; if (L >= nunits) return false;
        const int per = tm * tn, g = L / per, r = L % per; u.pm = tm * g + r % tm; u.pn = tn * g + r / tm; return true;
    }
    __device__ __forceinline__ void a_ready(const Unit&) const {}
    __device__ __forceinline__ void done(const Unit&) const {}
};

template <class Epi, class Sched, bool ALIGN_EPI = false, bool SP2 = false>
__device__ __forceinline__ void gemm_phase(PG8_LAS unsigned char* lds, const Gemm g, const Sched& S, const Epi& E, const int wid  ) {
    int lane_ = __builtin_amdgcn_mbcnt_hi(~0u, __builtin_amdgcn_mbcnt_lo(~0u, 0u)); asm volatile("" : "+v"(lane_));
    const int lane = lane_, tid = wid * 64 + lane, wr = wid >> 2, wc = wid & 3, fr = lane & 15, fq = lane >> 4;
    const int K = g.K, nt = K / BK;
    unsigned voffA[2], voffB[2];
#pragma unroll
    for (int i = 0; i < 2; ++i) { int R, C; stage_rc(tid * 16 + i * 8192, R, C); const int Rb = Epi::PERM ? ((R & ~31) + perm32(R & 31)) : R;
        voffA[i] = (unsigned)(R * K + C) * 2u; voffB[i] = (unsigned)(Rb * K + C) * 2u; }
    const size_t kstep = (size_t)(BK * 2);
    const size_t hstep = (size_t)HALF * K * 2;
    const size_t tstep = 2 * hstep;
    const unsigned ldsw = (unsigned)wid * 1024u;
    const int aoff = lds_byte(wr * 64 + fr, fq * 8), boff = lds_byte(wc * 32 + fr, fq * 8);
#define PG8_SA(b, h) (((b) * 2 + (h)) * HTB)
#define PG8_SB(b, h) ((4 + (b) * 2 + (h)) * HTB)
#define PG8_STAGE(bufoff, gbase, voff) do { _Pragma("unroll") for (int _i = 0; _i < 2; ++_i) \
        __builtin_amdgcn_global_load_lds((const unsigned*)((const char*)(gbase) + (voff)[_i]), (PG8_LAS unsigned*)(lds + (bufoff) + ldsw + _i * 8192), 16, 0, 0); } while (0)
#define PG8_LDA(dst, b, h) do { _Pragma("unroll") for (int m = 0; m < 4; ++m) _Pragma("unroll") for (int k = 0; k < 2; ++k) dst[m][k] = *(const PG8_LAS bf16x8*)(lds + PG8_SA(b, h) + aoff + m * 2048 + k * 1024); } while (0)
#define PG8_LDB(dst, b, h) do { _Pragma("unroll") for (int n = 0; n < 2; ++n) _Pragma("unroll") for (int k = 0; k < 2; ++k) dst[n][k] = *(const PG8_LAS bf16x8*)(lds + PG8_SB(b, h) + boff + n * 2048 + k * 1024); } while (0)
#define PG8_MMA(ai, bj, At, Bt) do { __builtin_amdgcn_s_setprio(1); _Pragma("unroll") for (int m = 0; m < 4; ++m) _Pragma("unroll") for (int n = 0; n < 2; ++n) _Pragma("unroll") for (int k = 0; k < 2; ++k) \
        acc[ai][bj][m][n] = __builtin_amdgcn_mfma_f32_16x16x32_bf16(Bt[n][k], At[m][k], acc[ai][bj][m][n], 0, 0, 0); __builtin_amdgcn_s_setprio(0); } while (0)
#define PG8_WAIT_V(n) asm volatile("s_waitcnt vmcnt(" #n ")" ::: "memory")
#define PG8_WAIT_L(n) asm volatile("s_waitcnt lgkmcnt(" #n ")" ::: "memory")
#define PG8_BAR __builtin_amdgcn_s_barrier()
#define PG8_SCHED __builtin_amdgcn_sched_barrier(0)
    Unit cur, nxt; int ui = 0;
    if (!S.next(0, cur)) return;
    f32x4 acc[2][2][4][2];
#pragma unroll
    for (int a = 0; a < 2; ++a)
#pragma unroll
        for (int b = 0; b < 2; ++b)
#pragma unroll
            for (int m = 0; m < 4; ++m)
#pragma unroll
                for (int n = 0; n < 2; ++n) acc[a][b][m][n] = (f32x4){0.f, 0.f, 0.f, 0.f};
    bf16x8 At[4][2], B0[2][2], B1[2][2];
    const char* cA = (const char*)g.A + (size_t)cur.pm * tstep; const char* cB = (const char*)g.Bt + (size_t)cur.pn * tstep;
    S.a_ready(cur);
    if constexpr (SP2) {
        PG8_STAGE(PG8_SB(0, 0), cB, voffB); PG8_STAGE(PG8_SB(0, 1), cB + hstep, voffB); PG8_STAGE(PG8_SA(0, 0), cA, voffA); PG8_STAGE(PG8_SA(0, 1), cA + hstep, voffA);
        if (wr == 1) PG8_BAR;
        PG8_WAIT_V(2); PG8_BAR;
        PG8_STAGE(PG8_SB(1, 0), cB + kstep, voffB); PG8_STAGE(PG8_SA(1, 0), cA + kstep, voffA); PG8_STAGE(PG8_SB(1, 1), cB + hstep + kstep, voffB);
        PG8_WAIT_V(6); PG8_BAR;
    } else {
        PG8_STAGE(PG8_SB(0, 0), cB, voffB); PG8_STAGE(PG8_SA(0, 0), cA, voffA); PG8_STAGE(PG8_SB(0, 1), cB + hstep, voffB); PG8_STAGE(PG8_SA(0, 1), cA + hstep, voffA);
        if (wr == 1) PG8_BAR;
        PG8_WAIT_V(4); PG8_BAR;
        PG8_STAGE(PG8_SB(1, 0), cB + kstep, voffB); PG8_STAGE(PG8_SA(1, 0), cA + kstep, voffA); PG8_STAGE(PG8_SB(1, 1), cB + hstep + kstep, voffB);
        PG8_WAIT_V(6); PG8_BAR;
    }
    for (;;) {
        const bool has_next = S.next(ui + 1, nxt);
        const char* nA = has_next ? (const char*)g.A + (size_t)nxt.pm * tstep : cA; const char* nB = has_next ? (const char*)g.Bt + (size_t)nxt.pn * tstep : cB;
        for (int t = 0; t < nt; t += 2) {
            const bool last = (t == nt - 2);
            const char* a1 = cA + (size_t)(t + 1) * kstep;
            const char* a2 = last ? nA : cA + (size_t)(t + 2) * kstep; const char* b2 = last ? nB : cB + (size_t)(t + 2) * kstep;
            const char* a3 = a2 + kstep; const char* b3 = b2 + kstep;
            if (last && has_next) S.a_ready(nxt);
            if constexpr (SP2) {
            PG8_LDB(B0, 0, 0); PG8_LDB(B1, 0, 1); PG8_SCHED; PG8_LDA(At, 0, 0); PG8_STAGE(PG8_SA(1, 1), a1 + hstep, voffA);
            PG8_WAIT_V(8); PG8_WAIT_L(0); PG8_BAR; PG8_MMA(0, 0, At, B0); PG8_MMA(0, 1, At, B1); PG8_BAR; PG8_SCHED;
            PG8_LDA(At, 0, 1); PG8_STAGE(PG8_SB(0, 0), b2, voffB); PG8_STAGE(PG8_SB(0, 1), b2 + hstep, voffB); PG8_STAGE(PG8_SA(0, 0), a2, voffA);
            PG8_WAIT_V(8); PG8_WAIT_L(0); PG8_BAR; PG8_MMA(1, 0, At, B0); PG8_MMA(1, 1, At, B1); PG8_BAR; PG8_SCHED;
            PG8_LDB(B0, 1, 0); PG8_LDB(B1, 1, 1); PG8_SCHED; PG8_LDA(At, 1, 0); PG8_STAGE(PG8_SA(0, 1), a2 + hstep, voffA);
            PG8_WAIT_V(8); PG8_WAIT_L(0); PG8_BAR; PG8_MMA(0, 0, At, B0); PG8_MMA(0, 1, At, B1); PG8_BAR; PG8_SCHED;
            PG8_LDA(At, 1, 1); PG8_STAGE(PG8_SB(1, 0), b3, voffB); PG8_STAGE(PG8_SB(1, 1), b3 + hstep, voffB); PG8_STAGE(PG8_SA(1, 0), a3, voffA);
            PG8_WAIT_V(8); PG8_WAIT_L(0); PG8_BAR; PG8_MMA(1, 0, At, B0); PG8_MMA(1, 1, At, B1); PG8_BAR; PG8_SCHED;
            } else {
            PG8_LDB(B0, 0, 0); PG8_SCHED; PG8_LDA(At, 0, 0); PG8_STAGE(PG8_SA(1, 1), a1 + hstep, voffA);
            PG8_WAIT_L(8); PG8_BAR; PG8_WAIT_L(0); PG8_MMA(0, 0, At, B0); PG8_BAR; PG8_SCHED;
            PG8_LDB(B1, 0, 1); PG8_STAGE(PG8_SB(0, 0), b2, voffB);
            PG8_BAR; PG8_WAIT_L(0); PG8_MMA(0, 1, At, B1); PG8_BAR;
            PG8_LDA(At, 0, 1); PG8_STAGE(PG8_SA(0, 0), a2, voffA);
            PG8_BAR; PG8_WAIT_L(0); PG8_MMA(1, 0, At, B0); PG8_BAR; PG8_SCHED;
            PG8_STAGE(PG8_SB(0, 1), b2 + hstep, voffB);
            PG8_WAIT_V(6); PG8_BAR; PG8_MMA(1, 1, At, B1); PG8_BAR;
            PG8_LDB(B0, 1, 0); PG8_SCHED; PG8_LDA(At, 1, 0); PG8_STAGE(PG8_SA(0, 1), a2 + hstep, voffA);
            PG8_WAIT_L(8); PG8_BAR; PG8_WAIT_L(0); PG8_MMA(0, 0, At, B0); PG8_BAR; PG8_SCHED;
            PG8_LDB(B1, 1, 1); PG8_STAGE(PG8_SB(1, 0), b3, voffB);
            PG8_BAR; PG8_WAIT_L(0); PG8_MMA(0, 1, At, B1); PG8_BAR;
            PG8_LDA(At, 1, 1); PG8_STAGE(PG8_SA(1, 0), a3, voffA);
            PG8_BAR; PG8_WAIT_L(0); PG8_MMA(1, 0, At, B0); PG8_BAR; PG8_SCHED;
            PG8_STAGE(PG8_SB(1, 1), b3 + hstep, voffB);
            PG8_WAIT_V(6); PG8_BAR; PG8_MMA(1, 1, At, B1); PG8_BAR;
            }
        }
        if constexpr (ALIGN_EPI) { if (wr == 0) PG8_BAR; }
        if constexpr (!Epi::AFTER_DRAIN) { E(acc, cur, wr, wc, fr, fq); S.done(cur); }
        if (!has_next) break;
#pragma unroll
        for (int a = 0; a < 2; ++a)
#pragma unroll
            for (int b = 0; b < 2; ++b)
#pragma unroll
                for (int m = 0; m < 4; ++m)
#pragma unroll
                    for (int n = 0; n < 2; ++n) acc[a][b][m][n] = (f32x4){0.f, 0.f, 0.f, 0.f};
        cur = nxt; cA = nA; cB = nB; ++ui;
        if constexpr (ALIGN_EPI) { if (wr == 1) PG8_BAR; }
    }
    PG8_WAIT_V(0);
    if constexpr (!ALIGN_EPI) { if (wr == 0) PG8_BAR; }
    PG8_BAR;
    if constexpr (Epi::AFTER_DRAIN) { E.fused(acc, cur, wr, wc, fr, fq, lds, wid, lane); S.done(cur); }
#undef PG8_SA
#undef PG8_SB
#undef PG8_STAGE
#undef PG8_LDA
#undef PG8_LDB
#undef PG8_MMA
#undef PG8_WAIT_V
#undef PG8_WAIT_L
#undef PG8_BAR
#undef PG8_SCHED
}
}

#define LAS __attribute__((address_space(3)))
typedef unsigned short bf16;
typedef float f32x4 __attribute__((ext_vector_type(4)));
typedef unsigned u32x4 __attribute__((ext_vector_type(4)));
typedef unsigned u32x2 __attribute__((ext_vector_type(2)));

constexpr int NWAVES = 8, NTHREADS = 512;
constexpr int BATCH = 8, SEQ = 2048, DM = 1024, TOK = BATCH * SEQ, DFF = 2816;
constexpr float RMS_EPS = 1e-6f, LN_EPS = 1e-5f;
constexpr float LOG2E = 1.4426950408889634f;
constexpr int LDS_BYTES = 147456;

#ifndef MK_PER_PHASE
#define MK_PER_PHASE 0
#endif

constexpr size_t MiB = 1u << 20;
constexpr size_t WS_ROPEA = 64 * 1024, WS_ROPED = 192 * 1024, WS_KMAT = 704 * 1024;
constexpr size_t WS_W0IN = 2 * MiB, WS_W0OUT = 7 * MiB, WS_W0GU = 9 * MiB, WS_W0DN = 20 * MiB;
constexpr size_t WS_WG1 = 2 * MiB, WS_WG2 = 14 * MiB;
constexpr size_t WS_W1IN = 26 * MiB, WS_W1UQ = 28 * MiB, WS_W1UKV = 29 * MiB, WS_W1GLU = 30 * MiB, WS_W1OUT = 31 * MiB, WS_W1GU = 33 * MiB, WS_W1DN = 44 * MiB;
constexpr size_t WS_H = 50 * MiB;
constexpr size_t WS_Q = 50 * MiB, WS_K = 66 * MiB, WS_V = 82 * MiB, WS_U = 98 * MiB;
constexpr size_t WS_Q1 = 50 * MiB, WS_KV1 = 86 * MiB;
constexpr size_t WS_MIX = 138 * MiB;
constexpr size_t WS_UT = 138 * MiB, WS_E = 146 * MiB, WS_YI = 150 * MiB, WS_XIN = 166 * MiB, WS_SSQ = 170 * MiB, WS_SSKV = 171 * MiB;
constexpr size_t WS_Z = 186 * MiB;
constexpr size_t WS_XN = 202 * MiB;
constexpr size_t WS_CQN = 234 * MiB, WS_CKVN = 242 * MiB, WS_KR = 250 * MiB;
constexpr size_t WS_END = 256 * MiB;

__device__ __forceinline__ float bf2f(unsigned short u) { return __uint_as_float((unsigned)u << 16); }
__device__ __forceinline__ unsigned f2bf(float f) { unsigned u = __builtin_bit_cast(unsigned, f); return (u + 0x7fffu + ((u >> 16) & 1u)) >> 16; }
__device__ __forceinline__ unsigned pk2(float lo, float hi) { return f2bf(lo) | (f2bf(hi) << 16); }
__device__ __forceinline__ float wave_sum(float v) {
#pragma unroll
    for (int o = 1; o < 64; o <<= 1) v += __shfl_xor(v, o);
    return v;
}
__device__ __forceinline__ float wave_max(float v) {
#pragma unroll
    for (int o = 1; o < 64; o <<= 1) v = fmaxf(v, __shfl_xor(v, o));
    return v;
}
__device__ __forceinline__ float bf_lo_(unsigned w) { return __uint_as_float(w << 16); }
__device__ __forceinline__ float bf_hi_(unsigned w) { return __uint_as_float(w & 0xffff0000u); }
__device__ __forceinline__ int fresh_lane() { int l = __builtin_amdgcn_mbcnt_hi(~0u, __builtin_amdgcn_mbcnt_lo(~0u, 0u)); asm volatile("" : "+v"(l)); return l; }
__device__ __forceinline__ float dot4(const f32x4 a, const f32x4 b) { return (a[0] * b[0] + a[1] * b[1]) + (a[2] * b[2] + a[3] * b[3]); }

struct Args { const float* in[42]; float* out; unsigned char* ws; int ph_lo, ph_hi; };
typedef const Args __attribute__((address_space(4)))* ArgsP;
__device__ __forceinline__ ArgsP launder(ArgsP p) { asm volatile("" : "+s"(p)); return p; }

__device__ __forceinline__ int permA(int p) { if (p >= 16) return p; const int g = p >> 3, j = p & 7; return (j < 4) ? 4 * g + j : 8 + 4 * g + (j - 4); }
__device__ __forceinline__ int permD(int p) { const int wl = p >> 5, fq = (p >> 3) & 3, j = p & 7; return (j < 4) ? 16 * wl + 4 * fq + j : 32 + 16 * wl + 4 * fq + (j - 4); }

struct WMat { int K, N, Ksrc; size_t off; };
__device__ __forceinline__ WMat wmat(int m) {
    switch (m) {
        case 0: return WMat{1024, 2560, 1024, WS_W0IN};
        case 1: return WMat{1024, 1024, 1024, WS_W0OUT};
        case 2: return WMat{1024, 5632, 1024, WS_W0GU};
        case 3: return WMat{2816, 1024, 2816, WS_W0DN};
        case 4: return WMat{1024, 768, 1024, WS_W1IN};
        case 5: return WMat{256, 1280, 256, WS_W1UQ};
        case 6: return WMat{256, 1536, 128, WS_W1UKV};
        case 7: return WMat{256, 256, 256, WS_W1GLU};
        case 8: return WMat{1024, 1024, 1024, WS_W1OUT};
        case 9: return WMat{1024, 5632, 1024, WS_W1GU};
        default: return WMat{2816, 1024, 2816, WS_W1DN};
    }
}
__device__ __forceinline__ const float* wsrc(ArgsP a, int m, int n, int& ld) {
    switch (m) {
        case 0: { ld = 2560; int c;
            if (n < 1024) c = (n & ~63) + permA(n & 63);
            else if (n < 1536) c = n;
            else { const int r = n - 1536, t = r >> 8, rr = r & 255; c = rr < 128 ? 1536 + 128 * t + rr : 2048 + 128 * t + (rr - 128); }
            return a->in[3] + c; }
        case 1: ld = 1024; return a->in[13] + n;
        case 2: { ld = 2816; const int j = n >> 8, rr = n & 255; return rr < 128 ? a->in[16] + 128 * j + rr : a->in[17] + 128 * j + (rr - 128); }
        case 3: ld = 1024; return a->in[18] + n;
        case 4: { ld = 704; if (n >= 704) return nullptr; return a->in[21] + (n < 640 ? n : 640 + permD(n - 640)); }
        case 5: { ld = 1152; if (n >= 1152) return nullptr; const int blk = n >> 6; return a->in[33] + ((blk % 3) == 2 ? (n & ~63) + permD(n & 63) : n); }
        case 6: ld = 1536; return a->in[35] + n;
        case 7: ld = 256; return a->in[30] + n;
        case 8: ld = 1024; return a->in[36] + n;
        case 9: { ld = 2816; const int j = n >> 8, rr = n & 255; return rr < 128 ? a->in[39] + 128 * j + rr : a->in[40] + 128 * j + (rr - 128); }
        default: ld = 1024; return a->in[41] + n;
    }
}
__device__ __forceinline__ void p0_transpose_item(ArgsP a, int m, const WMat w, int item, LAS float* scr, int lane) {
    const int nblk = w.N / 32, kb = item / nblk, nb = item % nblk, k0 = 64 * kb, n0 = 32 * nb;
    int ld; const float* src = wsrc(a, m, n0 + (lane & 31), ld);
    const float* ksc = (m == 5) ? a->in[32] : (m == 6) ? a->in[34] : nullptr;
#pragma unroll 8
    for (int i = 0; i < 32; ++i) { const int kk = 2 * i + (lane >> 5); const int k = k0 + kk;
        float v = (src != nullptr && k < w.Ksrc) ? src[(size_t)k * ld] : 0.f; if (ksc != nullptr && k < w.Ksrc) v *= ksc[k];
        scr[kk * 33 + (lane & 31)] = v; }
    asm volatile("s_waitcnt lgkmcnt(0)" ::: "memory");
    bf16* WT = (bf16*)(a->ws + w.off);
    const int c = lane & 7;
#pragma unroll
    for (int j = 0; j < 4; ++j) { const int n = (lane >> 3) + 8 * j; const LAS float* s = scr + (8 * c) * 33 + n;
        u32x4 o; o.x = pk2(s[0 * 33], s[1 * 33]); o.y = pk2(s[2 * 33], s[3 * 33]); o.z = pk2(s[4 * 33], s[5 * 33]); o.w = pk2(s[6 * 33], s[7 * 33]);
        *(u32x4*)(WT + (size_t)(n0 + n) * w.K + k0 + 8 * c) = o; }
    asm volatile("s_waitcnt lgkmcnt(0)" ::: "memory");
}

__device__ __forceinline__ void row_norm(const float* xrow, const float* g, bf16* xn, int lane) {
    f32x4 v[4]; float s = 0.f;
#pragma unroll
    for (int j = 0; j < 4; ++j) { v[j] = ((const f32x4*)xrow)[lane + 64 * j]; s += dot4(v[j], v[j]); }
    const float rstd = 1.0f / sqrtf(wave_sum(s) * (1.f / DM) + RMS_EPS);
#pragma unroll
    for (int j = 0; j < 4; ++j) { const f32x4 gg = ((const f32x4*)g)[lane + 64 * j]; const f32x4 t = v[j] * rstd * gg;
        u32x2 o; o.x = pk2(t[0], t[1]); o.y = pk2(t[2], t[3]); ((u32x2*)xn)[lane + 64 * j] = o; }
}
__device__ __forceinline__ void row_norm_res(const float* mix, const float* res, const float* gpost, float* out, const float* gpre, bf16* xn, int lane) {
    f32x4 v[4]; float s = 0.f;
#pragma unroll
    for (int j = 0; j < 4; ++j) { v[j] = ((const f32x4*)mix)[lane + 64 * j]; s += dot4(v[j], v[j]); }
    const float rstd = 1.0f / sqrtf(wave_sum(s) * (1.f / DM) + RMS_EPS);
    float s2 = 0.f;
#pragma unroll
    for (int j = 0; j < 4; ++j) { const f32x4 gg = ((const f32x4*)gpost)[lane + 64 * j]; const f32x4 r = ((const f32x4*)res)[lane + 64 * j];
        v[j] = r + v[j] * rstd * gg; ((f32x4*)out)[lane + 64 * j] = v[j]; s2 += dot4(v[j], v[j]); }
    if (xn) {
        const float rstd2 = 1.0f / sqrtf(wave_sum(s2) * (1.f / DM) + RMS_EPS);
#pragma unroll
        for (int j = 0; j < 4; ++j) { const f32x4 gg = ((const f32x4*)gpre)[lane + 64 * j]; const f32x4 t = v[j] * rstd2 * gg;
            u32x2 o; o.x = pk2(t[0], t[1]); o.y = pk2(t[2], t[3]); ((u32x2*)xn)[lane + 64 * j] = o; }
    }
}
__device__ __forceinline__ void ssm_pow(float lr, float li, float dt, int d, float& re, float& im) { const float mag = expf((float)d * (lr * dt)); const float ang = (float)d * (li * dt); re = mag * cosf(ang); im = mag * sinf(ang); }
__device__ __forceinline__ void ssm_f(float lr, float li, float dt, float& fre, float& fim) {
    float abr, abi; ssm_pow(lr, li, dt, 1, abr, abi); const float den = lr * lr + li * li, nre = abr - 1.f;
    fre = (nre * lr + abi * li) / den; fim = (abi * lr - nre * li) / den; }
__device__ __forceinline__ void ssm_kmat_item(ArgsP a, int g, int d, float* Kmat, int lane) {
    const int p = lane; const float lr = a->in[22][g * 64 + p], li = a->in[23][g * 64 + p], dt = expf(a->in[24][g]);
    float fre, fim, ar, ai; ssm_f(lr, li, dt, fre, fim); ssm_pow(lr, li, dt, d, ar, ai);
    const float tr0 = ar * fre - ai * fim, ti0 = ar * fim + ai * fre;
    float tre[16], tim[16];
#pragma unroll
    for (int h2 = 0; h2 < 16; ++h2) { const float br = a->in[25][(g * 64 + p) * 16 + h2], bi = a->in[26][(g * 64 + p) * 16 + h2]; tre[h2] = tr0 * br - ti0 * bi; tim[h2] = tr0 * bi + ti0 * br; }
    for (int h = 0; h < 16; ++h) {
        const float cr = a->in[27][(g * 16 + h) * 64 + p], ci = a->in[28][(g * 16 + h) * 64 + p];
        float keep = 0.f;
#pragma unroll
        for (int h2 = 0; h2 < 16; ++h2) { const float v = wave_sum(cr * tre[h2] - ci * tim[h2]); if (lane == h2) keep = v; }
        if (lane < 16) Kmat[((g * 32 + d) * 16 + h) * 16 + lane] = keep;
    }
}
__device__ __forceinline__ float dot8(const u32x4 a, const u32x4 b) {
    return (bf_lo_(a.x) * bf_lo_(b.x) + bf_hi_(a.x) * bf_hi_(b.x)) + (bf_lo_(a.y) * bf_lo_(b.y) + bf_hi_(a.y) * bf_hi_(b.y))
         + (bf_lo_(a.z) * bf_lo_(b.z) + bf_hi_(a.z) * bf_hi_(b.z)) + (bf_lo_(a.w) * bf_lo_(b.w) + bf_hi_(a.w) * bf_hi_(b.w));
}
__device__ __forceinline__ void attn_row_naive(const bf16* q1, const bf16* k1, int ldk1, int D1, const bf16* q2, const bf16* k2, int ldk2, int D2,
                                               const bf16* v, int ldv, int nk, LAS float* sc, int lane, float& o0, float& o1) {
    float mx = -INFINITY;
    for (int k = lane; k < nk; k += 64) {
        const bf16* kp = k1 + (size_t)k * ldk1; float d = 0.f;
        for (int i = 0; i < D1; i += 8) d += dot8(*(const u32x4*)(q1 + i), *(const u32x4*)(kp + i));
        if (D2) { const bf16* kp2 = k2 + (size_t)k * ldk2; for (int i = 0; i < D2; i += 8) d += dot8(*(const u32x4*)(q2 + i), *(const u32x4*)(kp2 + i)); }
        sc[k] = d; mx = fmaxf(mx, d);
    }
    mx = wave_max(mx);
    float sum = 0.f;
    for (int k = lane; k < nk; k += 64) { const float p = exp2f(sc[k] - mx); sc[k] = p; sum += p; }
    sum = wave_sum(sum);
    asm volatile("s_waitcnt lgkmcnt(0)" ::: "memory");
    float a0 = 0.f, a1 = 0.f;
    for (int k = 0; k < nk; ++k) { const float p = sc[k]; const bf16* vp = v + (size_t)k * ldv; a0 += p * bf2f(vp[lane]); a1 += p * bf2f(vp[lane + 64]); }
    const float inv = 1.f / sum; o0 = a0 * inv; o1 = a1 * inv;
    asm volatile("s_waitcnt lgkmcnt(0)" ::: "memory");
}

#define GAS __attribute__((address_space(1)))
typedef GAS unsigned gu32;
#define RLX_AGENT __ATOMIC_RELAXED, __HIP_MEMORY_SCOPE_AGENT
constexpr int CW_BAR = 4096;
constexpr size_t CTL_ZERO_BYTES = 64 * 1024;
constexpr int LDSCTL_OFF = 131072, MISC_OFF = LDSCTL_OFF + 320;
#define XB_TMO      128
#define XB_XCNT(j)  (256  + 64 * (j))
#define XB_XSUB(j)  (1280 + 64 * (j))
#define XB_XGEN(j)  (2304 + 64 * (j))
#define XB_TOP      3328
#define XB_TOPGEN   3392
#define XCD_BAR_WORDS 3456
#define XB_SPIN_CAP (1u << 18)

__device__ __forceinline__ unsigned xb_ld(unsigned* p)              { return __hip_atomic_load(p, __ATOMIC_RELAXED, __HIP_MEMORY_SCOPE_AGENT); }
__device__ __forceinline__ unsigned xb_add(unsigned* p, unsigned v) { return __hip_atomic_fetch_add(p, v, __ATOMIC_RELAXED, __HIP_MEMORY_SCOPE_AGENT); }
__device__ __forceinline__ unsigned xb_xcc_id() { return (unsigned)__builtin_amdgcn_s_getreg((3 << 11) | 20) & 0xFu; }
#define XB_SPIN(cond, bar) do { unsigned _sp = 0; while (cond) { __builtin_amdgcn_s_sleep(1); \
    if ((++_sp & 255u) == 0u) { if (xb_ld(&(bar)[XB_TMO])) break; if (_sp > XB_SPIN_CAP) { atomicAdd(&(bar)[XB_TMO], 1u); break; } } } } while (0)

struct XcdBarrier {
    unsigned* bar; unsigned x;
    volatile LAS unsigned* st;
};

__device__ __forceinline__ XcdBarrier xcd_barrier_post(unsigned* bar, volatile LAS unsigned* st, bool leader) {
    XcdBarrier b; b.bar = bar; b.x = xb_xcc_id(); b.st = st;
    if (leader) (void)xb_add(&bar[XB_XCNT(b.x)], 1u);
    return b;
}
__device__ __forceinline__ void xcd_barrier_complete(unsigned* bar, unsigned x, unsigned& nloc, unsigned& nx) {
    const unsigned G = gridDim.x * gridDim.y * gridDim.z;
    unsigned sum, cnt, mine, sp = 0u;
    for (;;) {
        sum = 0u; cnt = 0u; mine = 0u;
#pragma unroll
        for (unsigned j = 0; j < 16; ++j) { const unsigned c = xb_ld(&bar[XB_XCNT(j)]); sum += c; cnt += (c > 0u) ? 1u : 0u; mine = (j == x) ? c : mine; }
        if (sum == G) break;
        __builtin_amdgcn_s_sleep(1);
        if ((++sp & 255u) == 0u) { if (xb_ld(&bar[XB_TMO])) break; if (sp > XB_SPIN_CAP) { atomicAdd(&bar[XB_TMO], 1u); break; } }
    }
    nloc = mine > 0u ? mine : 1u; nx = cnt > 0u ? cnt : 1u;
}

__device__ __forceinline__ void xcd_barrier(const XcdBarrier& b, bool leader) {
    asm volatile("s_waitcnt vmcnt(0)" ::: "memory");
    __syncthreads();
    if (leader) {
        unsigned* bar = b.bar;
        __builtin_amdgcn_s_waitcnt(0);
        unsigned nloc = b.st[0], nx = b.st[1];
        if (nloc == 0u) { xcd_barrier_complete(bar, b.x, nloc, nx); b.st[0] = nloc; b.st[1] = nx; }
        const unsigned old = xb_add(&bar[XB_XSUB(b.x)], 1u);
        const unsigned gen = old / nloc;
        if (old + 1u == (gen + 1u) * nloc) {
            __builtin_amdgcn_fence(__ATOMIC_RELEASE, "agent");
            asm volatile("s_waitcnt vmcnt(0)" ::: "memory");
            const unsigned og = xb_add(&bar[XB_TOP], 1u);
            const unsigned tg = og / nx;
            if (og + 1u == (tg + 1u) * nx) xb_add(&bar[XB_TOPGEN], 1u);
            else XB_SPIN(xb_ld(&bar[XB_TOPGEN]) == tg, bar);
            __builtin_amdgcn_fence(__ATOMIC_ACQUIRE, "agent");
            xb_add(&bar[XB_XGEN(b.x)], 1u);
            asm volatile("s_waitcnt vmcnt(0)" ::: "memory");
        } else {
            XB_SPIN(xb_ld(&bar[XB_XGEN(b.x)]) == gen, bar);
            __builtin_amdgcn_fence(__ATOMIC_ACQUIRE, "agent");
            asm volatile("s_waitcnt vmcnt(0)" ::: "memory");
        }
    }
    __syncthreads();
}

namespace att {
typedef short bf16x8 __attribute__((ext_vector_type(8)));
typedef short s16x4 __attribute__((ext_vector_type(4)));
typedef short v4i16_t __attribute__((ext_vector_type(4)));
typedef float f32x16 __attribute__((ext_vector_type(16)));
typedef float f32x2_t __attribute__((ext_vector_type(2)));
typedef __bf16 bf16x2_t __attribute__((ext_vector_type(2)));
__device__ __forceinline__ int crow(int r, int hi) { return (r & 3) + 8 * (r >> 2) + 4 * hi; }
__device__ __forceinline__ unsigned cvtpk(float lo, float hi) { f32x2_t v = {lo, hi}; bf16x2_t b = __builtin_convertvector(v, bf16x2_t); return __builtin_bit_cast(unsigned, b); }
__device__ __forceinline__ s16x4 vtr(LAS const unsigned char* p) { return __builtin_bit_cast(s16x4, __builtin_amdgcn_ds_read_tr16_b64_v4i16((LAS v4i16_t*)p)); }
__device__ __forceinline__ float half_swap_max(float m) { auto rr = __builtin_amdgcn_permlane32_swap(__float_as_uint(m), __float_as_uint(m), false, false); return fmaxf(__uint_as_float(rr[0]), __uint_as_float(rr[1])); }
__device__ __forceinline__ float half_swap_sum(float m) { auto rr = __builtin_amdgcn_permlane32_swap(__float_as_uint(m), __float_as_uint(m), false, false); return __uint_as_float(rr[0]) + __uint_as_float(rr[1]); }
constexpr float THR = 8.0f;
constexpr int WSF_OFF = 131072 + 1024;
constexpr int XCH_OFF = 65536;

template <int DSTEPS>
__device__ __forceinline__ void tile_compute(LAS const unsigned char* kb, int kstep  , LAS const unsigned char* vb, const bf16x8 (&qr)[DSTEPS],
                                             f32x16 (&o)[4], f32x16& negm, float& mhat, float& lsum, LAS float* wsf, int r32, int hi) {
    f32x16 c0 = negm, c1 = negm;
#pragma unroll
    for (int d0 = 0; d0 < DSTEPS; ++d0) {
        const bf16x8 k0 = *(LAS const bf16x8*)(kb + d0 * kstep), k1 = *(LAS const bf16x8*)(kb + d0 * kstep + 512);
        c0 = __builtin_amdgcn_mfma_f32_32x32x16_bf16(k0, qr[d0], c0, 0, 0, 0);
        c1 = __builtin_amdgcn_mfma_f32_32x32x16_bf16(k1, qr[d0], c1, 0, 0, 0);
    }
    float rm = fmaxf(c0[0], c1[0]);
#pragma unroll
    for (int r = 1; r < 16; ++r) rm = fmaxf(rm, fmaxf(c0[r], c1[r]));
    rm = half_swap_max(rm);
    if (__any(rm > THR)) {
        const float dl = fmaxf(rm, 0.f); mhat += dl;
#pragma unroll
        for (int r = 0; r < 16; ++r) { c0[r] -= dl; c1[r] -= dl; negm[r] = -mhat; }
        const float f = exp2f(-dl); lsum *= f;
        if (hi == 0) wsf[r32] = f;
        asm volatile("s_waitcnt lgkmcnt(0)" ::: "memory");
#pragma unroll
        for (int r = 0; r < 16; ++r) { const float fr = wsf[crow(r, hi)];
#pragma unroll
            for (int e = 0; e < 4; ++e) o[e][r] *= fr; }
        asm volatile("s_waitcnt lgkmcnt(0)" ::: "memory");
    }
    float ls = 0.f;
#pragma unroll
    for (int r = 0; r < 16; ++r) { c0[r] = exp2f(c0[r]); c1[r] = exp2f(c1[r]); ls += c0[r] + c1[r]; }
    lsum += ls;
    u32x4 pw[4];
#pragma unroll
    for (int s = 0; s < 2; ++s) {
        pw[s]     = (u32x4){cvtpk(c0[8 * s], c0[8 * s + 1]), cvtpk(c0[8 * s + 2], c0[8 * s + 3]), cvtpk(c0[8 * s + 4], c0[8 * s + 5]), cvtpk(c0[8 * s + 6], c0[8 * s + 7])};
        pw[2 + s] = (u32x4){cvtpk(c1[8 * s], c1[8 * s + 1]), cvtpk(c1[8 * s + 2], c1[8 * s + 3]), cvtpk(c1[8 * s + 4], c1[8 * s + 5]), cvtpk(c1[8 * s + 6], c1[8 * s + 7])};
    }
#pragma unroll
    for (int e = 0; e < 4; ++e)
#pragma unroll
        for (int ks = 0; ks < 4; ++ks) {
            const s16x4 lo = vtr(vb + (e * 8 + 2 * ks) * 512), hh = vtr(vb + (e * 8 + 2 * ks + 1) * 512);
            const bf16x8 vf = {lo[0], lo[1], lo[2], lo[3], hh[0], hh[1], hh[2], hh[3]};
            o[e] = __builtin_amdgcn_mfma_f32_32x32x16_bf16(__builtin_bit_cast(bf16x8, pw[ks]), vf, o[e], 0, 0, 0);
        }
}

__device__ __forceinline__ void diff_unit(LAS unsigned char* lds, int b, int h, int qb, const bf16* Q, const bf16* K, const bf16* V, bf16* Y, float lam, const float* subln, int wave, int lane_in) {
    int lane = lane_in; asm volatile("" : "+v"(lane));
    const int r32 = lane & 31, hi = lane >> 5, c = wave >> 2, w4 = wave & 3;
    const int q0 = qb * 128, nt = 2 * qb + 2, jmax = 2 * qb + (w4 >> 1);
    const size_t tok0 = (size_t)b * SEQ;
    LAS float* wsf = (LAS float*)(lds + WSF_OFF) + wave * 64;
    bf16x8 qr[4];
    { const bf16* qp = Q + (tok0 + q0 + 32 * w4 + r32) * 512 + h * 128 + c * 64 + hi * 8;
#pragma unroll
      for (int d0 = 0; d0 < 4; ++d0) qr[d0] = *(const bf16x8*)(qp + 16 * d0); }
    const bf16* kg = K + (tok0 + lane) * 512 + h * 128 + wave * 8;
    const unsigned kl = wave * 1024 + lane * 16;
    const bf16* vg[2]; unsigned vl[2];
#pragma unroll
    for (int i = 0; i < 2; ++i) { const int rest = (lane >> 5) | (wave << 1) | (i << 4), eb = rest & 3, kb8 = rest >> 2, key = 8 * kb8 + ((lane >> 2) & 7), ech = 4 * eb + (lane & 3);
        vg[i] = V + (tok0 + key) * 512 + h * 128 + ech * 8; vl[i] = 16384 + (eb * 8 + kb8) * 512 + (key & 7) * 64 + (ech & 3) * 16; }
    const unsigned kfr = c * 8192 + hi * 1024 + r32 * 16;
    const unsigned vfr = 16384 + (4 * hi + ((lane & 15) >> 2)) * 64 + ((lane >> 4) & 1) * 32 + (lane & 3) * 8;
    u32x4 rk0, rk1, rv0, rv1;
#define DA_LOAD(j) do { const size_t go_ = (size_t)(j) * 64 * 512; rk0 = *(const u32x4*)(kg + go_); rk1 = *(const u32x4*)(kg + go_ + 64); rv0 = *(const u32x4*)(vg[0] + go_); rv1 = *(const u32x4*)(vg[1] + go_); } while (0)
#define DA_STORE(bo) do { *(LAS u32x4*)(lds + (bo) + kl) = rk0; *(LAS u32x4*)(lds + (bo) + 8192 + kl) = rk1; *(LAS u32x4*)(lds + (bo) + vl[0]) = rv0; *(LAS u32x4*)(lds + (bo) + vl[1]) = rv1; } while (0)
    f32x16 o[4];
#pragma unroll
    for (int e = 0; e < 4; ++e) o[e] = f32x16{};
    f32x16 negm = f32x16{}; float mhat = 0.f, lsum = 0.f;
    DA_LOAD(0); DA_STORE(0);
    __syncthreads();
    for (int j = 0; j < nt; ++j) {
        const unsigned bo = (j & 1) * 32768, bn = ((j + 1) & 1) * 32768;
        if (j + 1 < nt) DA_LOAD(j + 1);
        if (j <= jmax) tile_compute<4>(lds + bo + kfr, 2048, lds + bo + vfr, qr, o, negm, mhat, lsum, wsf, r32, hi);
        if (j + 1 < nt) DA_STORE(bn);
        __syncthreads();
    }
#undef DA_LOAD
#undef DA_STORE
    int r32e = r32, hie = hi; asm volatile("" : "+v"(r32e), "+v"(hie));
    lsum = half_swap_sum(lsum);
    if (hie == 0) wsf[32 + r32e] = lsum;
    asm volatile("s_waitcnt lgkmcnt(0)" ::: "memory");
#pragma unroll
    for (int r = 0; r < 16; ++r) { const float rl = 1.0f / wsf[32 + crow(r, hie)];
#pragma unroll
        for (int e = 0; e < 4; ++e) o[e][r] *= rl; }
    LAS float* xch = (LAS float*)(lds + XCH_OFF);
    if (c == 1) {
#pragma unroll
        for (int r = 0; r < 16; ++r)
#pragma unroll
            for (int e = 0; e < 4; ++e) xch[(32 * w4 + crow(r, hie)) * 128 + 32 * e + r32e] = o[e][r];
    }
    __syncthreads();
    if (c == 0) {
        float sub[4];
#pragma unroll
        for (int e = 0; e < 4; ++e) sub[e] = subln[32 * e + r32e] * 0.8f;
#pragma unroll
        for (int r = 0; r < 16; ++r) {
            float ss = 0.f;
#pragma unroll
            for (int e = 0; e < 4; ++e) { const float x = o[e][r] - lam * xch[(32 * w4 + crow(r, hie)) * 128 + 32 * e + r32e]; o[e][r] = x; ss += x * x; }
            ss += __shfl_xor(ss, 1); ss += __shfl_xor(ss, 2); ss += __shfl_xor(ss, 4); ss += __shfl_xor(ss, 8); ss += __shfl_xor(ss, 16);
            const float rstd = 1.0f / sqrtf(ss * (1.f / 128.f) + RMS_EPS);
            bf16* yp = Y + (tok0 + q0 + 32 * w4 + crow(r, hie)) * DM + h * 128 + r32e;
#pragma unroll
            for (int e = 0; e < 4; ++e) yp[32 * e] = (bf16)f2bf(o[e][r] * rstd * sub[e]);
        }
    }
}

__device__ __forceinline__ void mla_unit(LAS unsigned char* lds, int b, int h, int qb, const bf16* Q1, const bf16* KV1, const bf16* KR, bf16* Y, int wave, int lane_in) {
    int lane = lane_in; asm volatile("" : "+v"(lane));
    const int r32 = lane & 31, hi = lane >> 5;
    const int q0 = qb * 256, nt = 4 * qb + 4, jmax = 4 * qb + (wave >> 1);
    const size_t tok0 = (size_t)b * SEQ;
    LAS float* wsf = (LAS float*)(lds + WSF_OFF) + wave * 64;
    bf16x8 qr[12];
    { const bf16* qp = Q1 + (tok0 + q0 + 32 * wave + r32) * 1152 + h * 192 + hi * 8;
#pragma unroll
      for (int d0 = 0; d0 < 12; ++d0) qr[d0] = *(const bf16x8*)(qp + 16 * d0); }
    const bf16* kg = KV1 + (tok0 + lane) * 1536 + h * 256 + wave * 8;
    const bf16* kgr = KR + (tok0 + lane) * 64 + wave * 8;
    const unsigned kl = wave * 1024 + lane * 16;
    const bf16* vg[2]; unsigned vl[2];
#pragma unroll
    for (int i = 0; i < 2; ++i) { const int rest = (lane >> 5) | (wave << 1) | (i << 4), eb = rest & 3, kb8 = rest >> 2, key = 8 * kb8 + ((lane >> 2) & 7), ech = 4 * eb + (lane & 3);
        vg[i] = KV1 + (tok0 + key) * 1536 + h * 256 + 128 + ech * 8; vl[i] = 24576 + (eb * 8 + kb8) * 512 + (key & 7) * 64 + (ech & 3) * 16; }
    const unsigned kfr = hi * 1024 + r32 * 16;
    const unsigned vfr = 24576 + (4 * hi + ((lane & 15) >> 2)) * 64 + ((lane >> 4) & 1) * 32 + (lane & 3) * 8;
    u32x4 rk0, rk1, rk2, rv0, rv1;
#define ML_LOAD(j) do { const size_t t_ = (size_t)(j) * 64; rk0 = *(const u32x4*)(kg + t_ * 1536); rk1 = *(const u32x4*)(kg + t_ * 1536 + 64); rk2 = *(const u32x4*)(kgr + t_ * 64); \
        rv0 = *(const u32x4*)(vg[0] + t_ * 1536); rv1 = *(const u32x4*)(vg[1] + t_ * 1536); } while (0)
#define ML_STORE(bo) do { *(LAS u32x4*)(lds + (bo) + kl) = rk0; *(LAS u32x4*)(lds + (bo) + 8192 + kl) = rk1; *(LAS u32x4*)(lds + (bo) + 16384 + kl) = rk2; \
        *(LAS u32x4*)(lds + (bo) + vl[0]) = rv0; *(LAS u32x4*)(lds + (bo) + vl[1]) = rv1; } while (0)
    f32x16 o[4];
#pragma unroll
    for (int e = 0; e < 4; ++e) o[e] = f32x16{};
    f32x16 negm = f32x16{}; float mhat = 0.f, lsum = 0.f;
    ML_LOAD(0); ML_STORE(0);
    __syncthreads();
    for (int j = 0; j < nt; ++j) {
        const unsigned bo = (j & 1) * 40960, bn = ((j + 1) & 1) * 40960;
        if (j + 1 < nt) ML_LOAD(j + 1);
        if (j <= jmax) tile_compute<12>(lds + bo + kfr, 2048, lds + bo + vfr, qr, o, negm, mhat, lsum, wsf, r32, hi);
        if (j + 1 < nt) ML_STORE(bn);
        __syncthreads();
    }
#undef ML_LOAD
#undef ML_STORE
    int r32e = r32, hie = hi; asm volatile("" : "+v"(r32e), "+v"(hie));
    lsum = half_swap_sum(lsum);
    if (hie == 0) wsf[32 + r32e] = lsum;
    asm volatile("s_waitcnt lgkmcnt(0)" ::: "memory");
#pragma unroll
    for (int r = 0; r < 16; ++r) { const float rl = 1.0f / wsf[32 + crow(r, hie)];
        bf16* yp = Y + (tok0 + q0 + 32 * wave + crow(r, hie)) * DM + 256 + h * 128 + r32e;
#pragma unroll
        for (int e = 0; e < 4; ++e) yp[32 * e] = (bf16)f2bf(o[e][r] * rl); }
    asm volatile("s_waitcnt lgkmcnt(0)" ::: "memory");
}
}
constexpr int NPHASE = 18;
__global__ void __launch_bounds__(NTHREADS, 2) mega_fwd(Args a_unused) {
    extern __shared__ __attribute__((aligned(16))) unsigned char lds_raw[];
    LAS unsigned char* lds = (LAS unsigned char*)lds_raw;
    const int wave = __builtin_amdgcn_readfirstlane(threadIdx.x >> 6);
    const int G = gridDim.x, bid = blockIdx.x;
    const int gw = bid * NWAVES + wave, NGW = G * NWAVES;
    const ArgsP ap0 = (ArgsP)__builtin_amdgcn_kernarg_segment_ptr();
    for (int u = wave * 64 + fresh_lane(); u < (LDS_BYTES - LDSCTL_OFF) / 4; u += NTHREADS) ((LAS unsigned*)(lds + LDSCTL_OFF))[u] = 0u;
    __syncthreads();
    XcdBarrier bar; bar.bar = (unsigned*)(ap0->ws) + CW_BAR; bar.x = 0; bar.st = nullptr;
#if !MK_PER_PHASE
    bar = xcd_barrier_post((unsigned*)(ap0->ws) + CW_BAR, (volatile LAS unsigned*)(lds + MISC_OFF) + 8, wave == 0 && fresh_lane() == 0);
#endif
    const int lo = ap0->ph_lo, hi = ap0->ph_hi;
#define IN(k) (lo <= (k) && (k) < hi)
#define PTRS const int lane = fresh_lane(); (void)lane; ArgsP a = launder(ap0); unsigned char* ws = a->ws; (void)ws; \
        float* ropeA = (float*)(ws + WS_ROPEA); float* ropeD = (float*)(ws + WS_ROPED); bf16* XN = (bf16*)(ws + WS_XN); bf16* Y = (bf16*)(ws + WS_XN); \
        float* MIX = (float*)(ws + WS_MIX); bf16* Hb = (bf16*)(ws + WS_H); \
        bf16* Qb = (bf16*)(ws + WS_Q); bf16* Kb = (bf16*)(ws + WS_K); bf16* Vb = (bf16*)(ws + WS_V); bf16* Ub = (bf16*)(ws + WS_U); \
        bf16* Q1 = (bf16*)(ws + WS_Q1); bf16* KV1 = (bf16*)(ws + WS_KV1); bf16* Zb = (bf16*)(ws + WS_Z); float* Kmat = (float*)(ws + WS_KMAT); bf16* UT = (bf16*)(ws + WS_UT); float* Eb = (float*)(ws + WS_E); float* YI = (float*)(ws + WS_YI); bf16* XIN = (bf16*)(ws + WS_XIN); float* SSQ = (float*)(ws + WS_SSQ); float* SSKV = (float*)(ws + WS_SSKV); (void)Kmat; (void)UT; (void)Eb; (void)YI; (void)XIN; (void)SSQ; (void)SSKV; \
        bf16* CQN = (bf16*)(ws + WS_CQN); bf16* CKVN = (bf16*)(ws + WS_CKVN); bf16* KR = (bf16*)(ws + WS_KR); \
        float* out = a->out; (void)ropeA; (void)ropeD; (void)XN; (void)Y; (void)MIX; (void)Hb; (void)Qb; (void)Kb; (void)Vb; (void)Ub; (void)Q1; (void)KV1; (void)Zb; (void)CQN; (void)CKVN; (void)KR; (void)out;
#define SEAM(k) do { if (IN(k) && IN((k) + 1)) xcd_barrier(bar, wave == 0 && fresh_lane() == 0); } while (0)
#define GEMM_RUN(EpiT, E, Aptr, Bptr, M_, N_, K_, coff) do { int kk_ = (K_); asm volatile("" : "+s"(kk_));   \
        pg8::Gemm g_{(const pg8::bf16_t*)(Aptr), (const pg8::bf16_t*)(Bptr), M_, N_, kk_}; pg8::StaticOrder S_; \
        S_.init(M_, N_, G, (bid + (coff)) % G); pg8::gemm_phase<EpiT, pg8::StaticOrder, true, true>(lds, g_, S_, E, wave); } while (0)

    if (IN(0)) { PTRS
        LAS float* scr = (LAS float*)(lds + wave * 16384);
        int base = 0;
        for (int m = 0; m < 11; ++m) {
            const WMat w = wmat(m); const int nitems = (w.K / 64) * (w.N / 32);
            int j = (gw - base % NGW + NGW) % NGW;
            for (; j < nitems; j += NGW) p0_transpose_item(a, m, w, j, scr, lane);
            base += nitems;
        }
        for (int i = gw * 64 + lane; i < SEQ * 8; i += NGW * 64) { const int s = i >> 3, k = i & 7; const float inv = powf(500000.0f, -(float)(2 * k) / 16.0f); const float ang = (float)s * inv;
            ropeA[2 * i] = cosf(ang); ropeA[2 * i + 1] = sinf(ang); }
        for (int i = gw * 64 + lane; i < SEQ * 32; i += NGW * 64) { const int s = i >> 5, k = i & 31; const float inv = powf(10000.0f, -(float)(2 * k) / 64.0f); const float ang = (float)s * inv;
            ropeD[2 * i] = cosf(ang); ropeD[2 * i + 1] = sinf(ang); }
        for (int it = gw; it < 16 * 32; it += NGW) ssm_kmat_item(a, it >> 5, it & 31, Kmat, lane);
        for (int r = gw; r < TOK; r += NGW) row_norm(a->in[0] + (size_t)r * DM, a->in[1], XN + (size_t)r * DM, lane);
    }
    SEAM(0);
    if (IN(1)) { PTRS
        pg8::EpiProj0 E{Qb, Kb, Vb, Ub, ropeA, 0.125f * LOG2E};
        GEMM_RUN(pg8::EpiProj0, E, XN, ws + WS_W0IN, TOK, 2560, 1024, 0);
    }
    SEAM(1);
    if (IN(2)) { PTRS
        const float d1 = wave_sum(a->in[4][lane] * a->in[5][lane]), d2 = wave_sum(a->in[6][lane] * a->in[7][lane]);
        const float lam = expf(d1) - expf(d2) + 0.2f;
        const int vcu = (G % 8 == 0) ? (bid % 8) * (G / 8) + bid / 8 : bid;
        for (int p = vcu; p < 256; p += G) {
            const int bh = p >> 3, sidx = p & 7;
            att::diff_unit(lds, bh >> 2, bh & 3, 15 - sidx, Qb, Kb, Vb, Y, lam, a->in[8], wave, lane);
            att::diff_unit(lds, bh >> 2, bh & 3, sidx, Qb, Kb, Vb, Y, lam, a->in[8], wave, lane);
        }
        const float* dw_w = a->in[9]; const float* dw_b = a->in[10]; const float* ln_g = a->in[11]; const float* ln_b = a->in[12];
        for (int t = gw; t < TOK; t += NGW) {
            const int s = t % SEQ;
            f32x4 c0 = ((const f32x4*)dw_b)[2 * lane], c1 = ((const f32x4*)dw_b)[2 * lane + 1];
            for (int j = 0; j < 31; ++j) {
                if (s - 30 + j < 0) continue;
                const u32x4 uw = *(const u32x4*)(Ub + (size_t)(t - 30 + j) * 512 + 8 * lane);
                const f32x4 w0 = ((const f32x4*)(dw_w + j * 512))[2 * lane], w1 = ((const f32x4*)(dw_w + j * 512))[2 * lane + 1];
                c0[0] += bf_lo_(uw.x) * w0[0]; c0[1] += bf_hi_(uw.x) * w0[1]; c0[2] += bf_lo_(uw.y) * w0[2]; c0[3] += bf_hi_(uw.y) * w0[3];
                c1[0] += bf_lo_(uw.z) * w1[0]; c1[1] += bf_hi_(uw.z) * w1[1]; c1[2] += bf_lo_(uw.w) * w1[2]; c1[3] += bf_hi_(uw.w) * w1[3];
            }
            const float mu = wave_sum((c0[0] + c0[1]) + (c0[2] + c0[3]) + (c1[0] + c1[1]) + (c1[2] + c1[3])) * (1.f / 512.f);
            c0 = c0 - mu; c1 = c1 - mu;
            const float rstd = 1.0f / sqrtf(wave_sum(dot4(c0, c0) + dot4(c1, c1)) * (1.f / 512.f) + LN_EPS);
            const f32x4 g0 = ((const f32x4*)ln_g)[2 * lane], g1 = ((const f32x4*)ln_g)[2 * lane + 1], e0 = ((const f32x4*)ln_b)[2 * lane], e1 = ((const f32x4*)ln_b)[2 * lane + 1];
            f32x4 y0 = c0 * rstd * g0 + e0, y1 = c1 * rstd * g1 + e1;
#pragma unroll
            for (int k = 0; k < 4; ++k) { y0[k] = y0[k] * pg8::sigm(y0[k]); y1[k] = y1[k] * pg8::sigm(y1[k]); }
            u32x4 o; o.x = pk2(y0[0], y0[1]); o.y = pk2(y0[2], y0[3]); o.z = pk2(y1[0], y1[1]); o.w = pk2(y1[2], y1[3]);
            *(u32x4*)(Y + (size_t)t * DM + 512 + 8 * lane) = o;
        }
    }
    SEAM(2);
    if (IN(3)) { PTRS pg8::EpiF32 E{MIX, DM}; GEMM_RUN(pg8::EpiF32, E, Y, ws + WS_W0OUT, TOK, DM, DM, 0); }
    SEAM(3);
    if (IN(4)) { PTRS for (int r = gw; r < TOK; r += NGW) row_norm_res(MIX + (size_t)r * DM, a->in[0] + (size_t)r * DM, a->in[2], out + (size_t)r * DM, a->in[14], XN + (size_t)r * DM, lane); }
    SEAM(4);
    if (IN(5)) { PTRS pg8::EpiGateUp E{Hb, DFF}; GEMM_RUN(pg8::EpiGateUp, E, XN, ws + WS_W0GU, TOK, 2 * DFF, DM, 0); }
    SEAM(5);
    if (IN(6)) { PTRS pg8::EpiF32 E{MIX, DM}; GEMM_RUN(pg8::EpiF32, E, Hb, ws + WS_W0DN, TOK, DM, DFF, 0); }
    SEAM(6);
    if (IN(7)) { PTRS
        for (int r = gw; r < TOK; r += NGW) row_norm_res(MIX + (size_t)r * DM, out + (size_t)r * DM, a->in[15], out + (size_t)r * DM, a->in[19], XN + (size_t)r * DM, lane);
        bf16* WG1 = (bf16*)(ws + WS_WG1); bf16* WG2 = (bf16*)(ws + WS_WG2);
        for (int idx = gw * 64 + lane; idx < 16 * 768 * 64; idx += NGW * 64) {
            const int k0 = (idx & 63) * 8, n = (idx >> 6) % 768, g = idx / (64 * 768), i = k0 >> 4, h0 = k0 & 15;
            float v[8];
#pragma unroll
            for (int e = 0; e < 8; ++e) v[e] = 0.f;
            if (n < 128) {
                const int p = n & 63; const float lr = a->in[22][g * 64 + p], li = a->in[23][g * 64 + p], dt = expf(a->in[24][g]);
                float fre, fim, ar, ai; ssm_f(lr, li, dt, fre, fim); ssm_pow(lr, li, dt, 31 - i, ar, ai);
                const float tr0 = ar * fre - ai * fim, ti0 = ar * fim + ai * fre;
#pragma unroll
                for (int e = 0; e < 8; ++e) { const float br = a->in[25][(g * 64 + p) * 16 + h0 + e], bi = a->in[26][(g * 64 + p) * 16 + h0 + e];
                    v[e] = (n < 64) ? tr0 * br - ti0 * bi : tr0 * bi + ti0 * br; }
            } else if (n < 640) {
                const int j = (n - 128) >> 4, h = (n - 128) & 15;
                if (i <= j) { const float* kp = Kmat + ((g * 32 + (j - i)) * 16 + h) * 16 + h0; const f32x4 k0v = *(const f32x4*)kp, k1v = *(const f32x4*)(kp + 4);
                    v[0] = k0v[0]; v[1] = k0v[1]; v[2] = k0v[2]; v[3] = k0v[3]; v[4] = k1v[0]; v[5] = k1v[1]; v[6] = k1v[2]; v[7] = k1v[3]; }
            }
            u32x4 o; o.x = pk2(v[0], v[1]); o.y = pk2(v[2], v[3]); o.z = pk2(v[4], v[5]); o.w = pk2(v[6], v[7]);
            *(u32x4*)(WG1 + ((size_t)(g * 768 + n) * 512 + k0)) = o;
        }
        for (int idx = gw * 64 + lane; idx < 16 * 512 * 32; idx += NGW * 64) {
            const int k0 = (idx & 31) * 8, n = (idx >> 5) & 511, g = idx >> 14, j = n >> 4, h = n & 15;
            float v[8];
#pragma unroll
            for (int e = 0; e < 8; ++e) v[e] = 0.f;
            if (k0 < 128) { const float dt = expf(a->in[24][g]);
#pragma unroll
                for (int e = 0; e < 8; ++e) { const int p = (k0 & 63) + e; float ar, ai; ssm_pow(a->in[22][g * 64 + p], a->in[23][g * 64 + p], dt, j + 1, ar, ai);
                    const float cr = a->in[27][(g * 16 + h) * 64 + p], ci = a->in[28][(g * 16 + h) * 64 + p];
                    v[e] = (k0 < 64) ? cr * ar - ci * ai : -(cr * ai + ci * ar); } }
            u32x4 o; o.x = pk2(v[0], v[1]); o.y = pk2(v[2], v[3]); o.z = pk2(v[4], v[5]); o.w = pk2(v[6], v[7]);
            *(u32x4*)(WG2 + ((size_t)(g * 512 + n) * 256 + k0)) = o;
        }
    }
    SEAM(7);
    if (IN(8)) { PTRS pg8::EpiProj1 E{UT, CQN, CKVN, KR, SSQ, SSKV, ropeD}; GEMM_RUN(pg8::EpiProj1, E, XN, ws + WS_W1IN, TOK, 768, DM, 0); }
    SEAM(8);
    if (IN(9)) { PTRS
        { pg8::EpiSsmG1 E{Eb, YI}; int kk_ = 512; asm volatile("" : "+s"(kk_));
          pg8::Gemm g_{(const pg8::bf16_t*)UT, (const pg8::bf16_t*)(ws + WS_WG1), 16 * 512, 16 * 768, kk_}; pg8::BatchOrder S_{2, 3, 96, G, (bid + 64) % G};
          pg8::gemm_phase<pg8::EpiSsmG1, pg8::BatchOrder, true, true>(lds, g_, S_, E, wave); }
        { pg8::EpiQup E{Q1, ropeD, 0.07216878364870323f * LOG2E, SSQ}; GEMM_RUN(pg8::EpiQup, E, CQN, ws + WS_W1UQ, TOK, 1280, 256, 0); }
        { pg8::EpiKVup E{KV1, SSKV}; GEMM_RUN(pg8::EpiKVup, E, CKVN, ws + WS_W1UKV, TOK, 1536, 256, 192); }
    }
    SEAM(9);
    if (IN(10)) { PTRS
        if (gw < BATCH * 16) {
            const int b = gw >> 4, g = gw & 15, p = lane;
            float ar, ai; ssm_pow(a->in[22][g * 64 + p], a->in[23][g * 64 + p], expf(a->in[24][g]), 32, ar, ai);
            float xr = 0.f, xi = 0.f;
            for (int c0 = 0; c0 < 64; c0 += 16) {
                float er[16], ei[16];
#pragma unroll
                for (int k = 0; k < 16; ++k) { const float* ep = Eb + ((size_t)g * 512 + b * 64 + c0 + k) * 128; er[k] = ep[p]; ei[k] = ep[64 + p]; }
#pragma unroll
                for (int k = 0; k < 16; ++k) { bf16* xp = XIN + ((size_t)g * 512 + b * 64 + c0 + k) * 256;
                    xp[p] = (bf16)f2bf(xr); xp[64 + p] = (bf16)f2bf(xi); xp[128 + p] = 0; xp[192 + p] = 0;
                    const float nr = ar * xr - ai * xi + er[k], ni = ar * xi + ai * xr + ei[k]; xr = nr; xi = ni; }
            }
        }
    }
    SEAM(10);
    if (IN(11)) { PTRS
        pg8::EpiSsmOut E{YI, UT, a->in[29], Zb}; int kk_ = 256; asm volatile("" : "+s"(kk_));
        pg8::Gemm g_{(const pg8::bf16_t*)XIN, (const pg8::bf16_t*)(ws + WS_WG2), 16 * 512, 16 * 512, kk_}; pg8::BatchOrder S_{2, 2, 64, G, bid};
        pg8::gemm_phase<pg8::EpiSsmOut, pg8::BatchOrder, true, true>(lds, g_, S_, E, wave);
    }
    SEAM(11);
    if (IN(12)) { PTRS
        const int vcu = (G % 8 == 0) ? (bid % 8) * (G / 8) + bid / 8 : bid;
        { pg8::EpiSsmGate E{Zb, a->in[31], Y, DM}; int kk_ = 256; asm volatile("" : "+s"(kk_));
          pg8::Gemm g_{(const pg8::bf16_t*)Zb, (const pg8::bf16_t*)(ws + WS_W1GLU), TOK, 256, kk_}; pg8::StaticOrder S_; S_.init(TOK, 256, G, (G == 256) ? (vcu >= 192 ? vcu - 192 : vcu + 64) : bid);
          pg8::gemm_phase<pg8::EpiSsmGate, pg8::StaticOrder, true, true>(lds, g_, S_, E, wave); }
        for (int p = vcu; p < 192; p += G) {
            const int bh = p >> 2, sidx = p & 3;
            att::mla_unit(lds, bh / 6, bh % 6, 7 - sidx, Q1, KV1, KR, Y, wave, lane);
            att::mla_unit(lds, bh / 6, bh % 6, sidx, Q1, KV1, KR, Y, wave, lane);
        }
    }
    SEAM(12);
    if (IN(13)) { PTRS pg8::EpiF32 E{MIX, DM}; GEMM_RUN(pg8::EpiF32, E, Y, ws + WS_W1OUT, TOK, DM, DM, 0); }
    SEAM(13);
    if (IN(14)) { PTRS for (int r = gw; r < TOK; r += NGW) row_norm_res(MIX + (size_t)r * DM, out + (size_t)r * DM, a->in[20], out + (size_t)r * DM, a->in[37], XN + (size_t)r * DM, lane); }
    SEAM(14);
    if (IN(15)) { PTRS pg8::EpiGateUp E{Hb, DFF}; GEMM_RUN(pg8::EpiGateUp, E, XN, ws + WS_W1GU, TOK, 2 * DFF, DM, 0); }
    SEAM(15);
    if (IN(16)) { PTRS pg8::EpiF32 E{MIX, DM}; GEMM_RUN(pg8::EpiF32, E, Hb, ws + WS_W1DN, TOK, DM, DFF, 0); }
    SEAM(16);
    if (IN(17)) { PTRS for (int r = gw; r < TOK; r += NGW) row_norm_res(MIX + (size_t)r * DM, out + (size_t)r * DM, a->in[38], out + (size_t)r * DM, nullptr, nullptr, lane); }
#undef IN
#undef PTRS
#undef SEAM
#undef GEMM_RUN
}

extern "C" void kernel_launch(void* const* d_in, const int* in_sizes, int n_in, void* d_out, int out_size, void* d_ws, size_t ws_size, hipStream_t stream) {
    static int grid = 0;
    if (grid == 0) {
        if (n_in != 42 || out_size != TOK * DM || ws_size < WS_END) { fprintf(stderr, "kernel_launch: unexpected problem shape (n_in %d out %d ws %zu)\n", n_in, out_size, ws_size); grid = -1; return; }
        int dev = 0, cus = 0, per_cu = 0;
        (void)hipGetDevice(&dev);
        (void)hipDeviceGetAttribute(&cus, hipDeviceAttributeMultiprocessorCount, dev);
        if (hipFuncSetAttribute((const void*)mega_fwd, hipFuncAttributeMaxDynamicSharedMemorySize, LDS_BYTES) != hipSuccess) { fprintf(stderr, "kernel_launch: hipFuncSetAttribute failed\n"); grid = -1; return; }
        if (hipOccupancyMaxActiveBlocksPerMultiprocessor(&per_cu, (const void*)mega_fwd, NTHREADS, LDS_BYTES) != hipSuccess || per_cu < 1) { fprintf(stderr, "kernel_launch: occupancy query says %d blocks per CU\n", per_cu); grid = -1; return; }
        (void)hipGetLastError();
        grid = cus;
        if (grid > 256) grid = 256;
        fprintf(stderr, "kernel_launch: %d CUs, %d blocks/CU by the occupancy query, grid %d\n", cus, per_cu, grid);
    }
    if (grid < 0) return;
    if (hipMemsetAsync(d_ws, 0, CTL_ZERO_BYTES, stream) != hipSuccess) { fprintf(stderr, "kernel_launch: hipMemsetAsync failed\n"); return; }
    Args a{};
    for (int i = 0; i < 42; ++i) a.in[i] = (const float*)d_in[i];
    a.out = (float*)d_out; a.ws = (unsigned char*)d_ws;
#if MK_PER_PHASE
    for (int p = 0; p < NPHASE; ++p) {
        a.ph_lo = p; a.ph_hi = p + 1;
        void* args[] = {&a};
        hipError_t e = hipLaunchCooperativeKernel((void*)mega_fwd, dim3(grid), dim3(NTHREADS), args, LDS_BYTES, stream);
        if (e != hipSuccess) { fprintf(stderr, "kernel_launch: phase %d launch failed: %s\n", p, hipGetErrorString(e)); break; }
    }
#else
    a.ph_lo = 0; a.ph_hi = NPHASE;
    void* args[] = {&a};
    hipError_t e = hipLaunchCooperativeKernel((void*)mega_fwd, dim3(grid), dim3(NTHREADS), args, LDS_BYTES, stream);
    if (e != hipSuccess) fprintf(stderr, "kernel_launch: cooperative launch failed: %s (grid %d)\n", hipGetErrorString(e), grid);
#endif
}
```
